# Optimizing an MI355X kernel written in HIP

```python
import math
import jax, jax.numpy as jnp
from jax import lax
import numpy as np

D_MODEL = 1024
BATCH = 8
SEQ = 2048
DEPTH = 2

N_MIXERS = 2
A_HEADS = 16
A_KV_HEADS = 2
A_HEAD_DIM = 64
WINDOW = 128
BLOCK = 128
NUM_BUCKETS = 32
MAX_DISTANCE = 128
B_HEADS = 16
Q_LORA = 256
KV_LORA = 128
QK_NOPE = 64
QK_ROPE = 32
V_DIM = 64
ROPE_BASE = 10000.0
D_FF = 2816
EPS = 1e-6
NEG = -1e30

N_A_LAYERS = (DEPTH + 1) // 2
N_B_LAYERS = DEPTH // 2
A_IN_COLS = (A_HEADS + 2 * A_KV_HEADS) * A_HEAD_DIM
B_IN_COLS = Q_LORA + KV_LORA + QK_ROPE

kernel_name = "hybrid_swa_sink_mla_macaron"


def rmsnorm(x, g):
    xf = x.astype(jnp.float32)
    y = xf * lax.rsqrt(jnp.mean(xf * xf, axis=-1, keepdims=True) + EPS)
    return (y * g.astype(jnp.float32)).astype(x.dtype)


def swiglu(h, wg, wu, wd):
    return (jax.nn.silu(h @ wg) * (h @ wu)) @ wd


def t5_bucket(dist):
    n = jnp.maximum(dist, 0)
    max_exact = NUM_BUCKETS // 2
    large = max_exact + (jnp.log(jnp.maximum(n, 1).astype(jnp.float32) / max_exact)
                         / math.log(MAX_DISTANCE / max_exact)
                         * (NUM_BUCKETS - max_exact)).astype(jnp.int32)
    large = jnp.minimum(large, NUM_BUCKETS - 1)
    return jnp.where(n < max_exact, n, large)


def apply_rope(t, pos):
    half = QK_ROPE // 2
    inv_freq = ROPE_BASE ** (-jnp.arange(0, QK_ROPE, 2, dtype=jnp.float32) / QK_ROPE)
    ang = pos.astype(jnp.float32)[..., None] * inv_freq
    cos = jnp.cos(ang)[:, :, None, :]
    sin = jnp.sin(ang)[:, :, None, :]
    t1, t2 = t[..., :half].astype(jnp.float32), t[..., half:].astype(jnp.float32)
    return jnp.concatenate([t1 * cos - t2 * sin, t2 * cos + t1 * sin], axis=-1).astype(t.dtype)


def band(t, nb):
    B = t.shape[0]
    rest = t.shape[2:]
    pad = jnp.zeros((B, BLOCK) + rest, t.dtype)
    tp = jnp.concatenate([pad, t], axis=1).reshape((B, nb + 1, BLOCK) + rest)
    return jnp.concatenate([tp[:, :-1], tp[:, 1:]], axis=2)


def sliding_window_attention(h, pos, rel_bias, w_in, q_gain, k_gain, sinks, w_out):
    B, S, _ = h.shape
    nb = S // BLOCK
    G = A_HEADS // A_KV_HEADS
    qkv = h @ w_in
    q, k, v = jnp.split(qkv, [A_HEADS * A_HEAD_DIM, (A_HEADS + A_KV_HEADS) * A_HEAD_DIM], axis=-1)
    q = rmsnorm(q.reshape(B, S, A_HEADS, A_HEAD_DIM), q_gain)
    k = rmsnorm(k.reshape(B, S, A_KV_HEADS, A_HEAD_DIM), k_gain)
    v = v.reshape(B, S, A_KV_HEADS, A_HEAD_DIM)
    q = q.reshape(B, nb, BLOCK, A_KV_HEADS, G, A_HEAD_DIM)
    kb, vb = band(k, nb), band(v, nb)
    posb = band(pos, nb)
    scale = A_HEAD_DIM ** -0.5
    scores = jnp.einsum('bnqkgd,bnskd->bnkgqs', q, kb).astype(jnp.float32) * scale
    dist = pos.reshape(B, nb, BLOCK)[..., :, None] - posb[..., None, :]
    bias = rel_bias[t5_bucket(dist)].astype(jnp.float32)
    bias = bias.reshape(B, nb, BLOCK, 2 * BLOCK, A_KV_HEADS, G).transpose(0, 1, 4, 5, 2, 3)
    scores = scores + bias
    qi = jnp.arange(BLOCK)[:, None] + BLOCK
    si = jnp.arange(2 * BLOCK)[None, :]
    rel = qi - si
    blk = jnp.arange(nb)[:, None, None]
    valid = (rel >= 0) & (rel < WINDOW) & (blk * BLOCK + si - BLOCK >= 0)
    scores = jnp.where(valid[None, :, None, None], scores, NEG)
    sink = sinks.astype(jnp.float32).reshape(A_KV_HEADS, G)[None, None, :, :, None, None]
    m = jnp.maximum(jnp.max(scores, axis=-1, keepdims=True), sink)
    p = jnp.exp(scores - m)
    denom = jnp.sum(p, axis=-1, keepdims=True) + jnp.exp(sink - m)
    probs = (p / denom).astype(v.dtype)
    o = jnp.einsum('bnkgqs,bnskd->bnqkgd', probs, vb).reshape(B, S, A_HEADS * A_HEAD_DIM)
    return o @ w_out


def latent_attention(h, pos, w_in, q_norm, kv_norm, w_uq, w_ukv, q_gain, k_gain, w_out):
    B, S, _ = h.shape
    nb = S // BLOCK
    dqk = QK_NOPE + QK_ROPE
    c = h @ w_in
    c_q, c_kv, k_rope = jnp.split(c, [Q_LORA, Q_LORA + KV_LORA], axis=-1)
    q = (rmsnorm(c_q, q_norm) @ w_uq).reshape(B, S, B_HEADS, dqk)
    kv = (rmsnorm(c_kv, kv_norm) @ w_ukv).reshape(B, S, B_HEADS, QK_NOPE + V_DIM)
    k_nope, v = jnp.split(kv, [QK_NOPE], axis=-1)
    k = jnp.concatenate(
        [k_nope, jnp.broadcast_to(k_rope[:, :, None, :], (B, S, B_HEADS, QK_ROPE))], axis=-1)
    q = rmsnorm(q, q_gain)
    k = rmsnorm(k, k_gain)
    q = jnp.concatenate([q[..., :QK_NOPE], apply_rope(q[..., QK_NOPE:], pos)], axis=-1)
    k = jnp.concatenate([k[..., :QK_NOPE], apply_rope(k[..., QK_NOPE:], pos)], axis=-1)
    scale = dqk ** -0.5
    qb = q.reshape(B, nb, BLOCK, B_HEADS, dqk).transpose(1, 0, 2, 3, 4)
    key_idx = jnp.arange(S)

    def attend(args):
        q_blk, n = args
        s = jnp.einsum('bqhd,bshd->bhqs', q_blk, k).astype(jnp.float32) * scale
        q_idx = n * BLOCK + jnp.arange(BLOCK)
        s = jnp.where(key_idx[None, :] <= q_idx[:, None], s, NEG)
        p = jax.nn.softmax(s, axis=-1).astype(v.dtype)
        return jnp.einsum('bhqs,bshd->bqhd', p, v)

    o = lax.map(attend, (qb, jnp.arange(nb)))
    o = o.transpose(1, 0, 2, 3, 4).reshape(B, S, B_HEADS * V_DIM)
    return o @ w_out


def setup_inputs(seed: int = 0) -> dict:
    key = jax.random.key(seed)
    ks = jax.random.split(key, 32)
    f32 = jnp.float32

    def w(k, shape, fan_in):
        return jax.random.normal(k, shape, f32) * (fan_in ** -0.5)

    def gain(k, shape):
        return 1.0 + 0.05 * jax.random.normal(k, shape, f32)

    x = jax.random.normal(ks[0], (BATCH, SEQ, D_MODEL), f32)
    offsets = jax.random.randint(ks[1], (BATCH, 1), 0, 64, dtype=jnp.int32)
    positions = (jnp.arange(SEQ, dtype=jnp.int32)[None, :] + offsets).astype(jnp.int32)
    return {
        "x": x,
        "positions": positions,
        "rel_bias": 0.5 * jax.random.normal(ks[2], (NUM_BUCKETS, A_HEADS), f32),
        "ffn_norm1": gain(ks[3], (DEPTH, D_MODEL)),
        "ffn1_wg": w(ks[4], (DEPTH, D_MODEL, D_FF), D_MODEL),
        "ffn1_wu": w(ks[5], (DEPTH, D_MODEL, D_FF), D_MODEL),
        "ffn1_wd": w(ks[6], (DEPTH, D_FF, D_MODEL), D_FF),
        "mix_norm": gain(ks[7], (DEPTH, D_MODEL)),
        "ffn_norm2": gain(ks[8], (DEPTH, D_MODEL)),
        "ffn2_wg": w(ks[9], (DEPTH, D_MODEL, D_FF), D_MODEL),
        "ffn2_wu": w(ks[10], (DEPTH, D_MODEL, D_FF), D_MODEL),
        "ffn2_wd": w(ks[11], (DEPTH, D_FF, D_MODEL), D_FF),
        "a_w_in": w(ks[12], (N_A_LAYERS, D_MODEL, A_IN_COLS), D_MODEL),
        "a_q_gain": gain(ks[13], (N_A_LAYERS, A_HEAD_DIM)),
        "a_k_gain": gain(ks[14], (N_A_LAYERS, A_HEAD_DIM)),
        "a_sinks": jax.random.normal(ks[15], (N_A_LAYERS, A_HEADS), f32),
        "a_w_out": w(ks[16], (N_A_LAYERS, A_HEADS * A_HEAD_DIM, D_MODEL), A_HEADS * A_HEAD_DIM),
        "b_w_in": w(ks[17], (N_B_LAYERS, D_MODEL, B_IN_COLS), D_MODEL),
        "b_q_norm": gain(ks[18], (N_B_LAYERS, Q_LORA)),
        "b_kv_norm": gain(ks[19], (N_B_LAYERS, KV_LORA)),
        "b_w_uq": w(ks[20], (N_B_LAYERS, Q_LORA, B_HEADS * (QK_NOPE + QK_ROPE)), Q_LORA),
        "b_w_ukv": w(ks[21], (N_B_LAYERS, KV_LORA, B_HEADS * (QK_NOPE + V_DIM)), KV_LORA),
        "b_q_gain": gain(ks[22], (N_B_LAYERS, QK_NOPE + QK_ROPE)),
        "b_k_gain": gain(ks[23], (N_B_LAYERS, QK_NOPE + QK_ROPE)),
        "b_w_out": w(ks[24], (N_B_LAYERS, B_HEADS * V_DIM, D_MODEL), B_HEADS * V_DIM),
    }


def reference(x, positions, rel_bias, ffn_norm1, ffn1_wg, ffn1_wu, ffn1_wd, mix_norm,
              ffn_norm2, ffn2_wg, ffn2_wu, ffn2_wd, a_w_in, a_q_gain, a_k_gain, a_sinks,
              a_w_out, b_w_in, b_q_norm, b_kv_norm, b_w_uq, b_w_ukv, b_q_gain, b_k_gain,
              b_w_out):
    for i in range(DEPTH):
        x = x + 0.5 * swiglu(rmsnorm(x, ffn_norm1[i]), ffn1_wg[i], ffn1_wu[i], ffn1_wd[i])
        h = rmsnorm(x, mix_norm[i])
        j = i // N_MIXERS
        if i % N_MIXERS == 0:
            x = x + sliding_window_attention(h, positions, rel_bias, a_w_in[j], a_q_gain[j],
                                             a_k_gain[j], a_sinks[j], a_w_out[j])
        else:
            x = x + latent_attention(h, positions, b_w_in[j], b_q_norm[j], b_kv_norm[j],
                                     b_w_uq[j], b_w_ukv[j], b_q_gain[j], b_k_gain[j], b_w_out[j])
        x = x + 0.5 * swiglu(rmsnorm(x, ffn_norm2[i]), ffn2_wg[i], ffn2_wu[i], ffn2_wd[i])
    return x
```

```cpp
#include <hip/hip_runtime.h>
#include <cstdio>
#include <cstdint>
__device__ __forceinline__ int tid_of(int wv) { int t; asm volatile("v_mbcnt_lo_u32_b32 %0, -1, 0\n\tv_mbcnt_hi_u32_b32 %0, -1, %0" : "=v"(t)); return t + wv * 64; }
namespace pg8 {
#define PG8_LAS __attribute__((address_space(3)))
typedef unsigned short bf16_t;
typedef short bf16x8 __attribute__((ext_vector_type(8)));
typedef float f32x4 __attribute__((ext_vector_type(4)));
typedef unsigned u32x4 __attribute__((ext_vector_type(4)));
constexpr int BM = 256, BK = 64, HALF = 128, HTB = HALF * BK * 2  , STAGE_BYTES = 8 * HTB, NXCD = 8, WGM = 8;

__host__ __device__ __forceinline__ int lds_byte(int r, int c) { const int st = (r >> 4) * 2 + (c >> 5), rr = r & 15, cc = c & 31, ob = rr * 64 + cc * 2; return st * 1024 + (ob ^ (((ob >> 9) & 1) << 5)); }
__host__ __device__ __forceinline__ void stage_rc(int b, int& R, int& C) { const int st = b / 1024, sb = b % 1024, swz = sb ^ (((sb >> 9) & 1) << 5); R = (st >> 1) * 16 + swz / 64; C = (st & 1) * 32 + (swz % 64) / 2; }
__host__ __device__ __forceinline__ int perm32(int rho) { const int n = rho >> 4, i = rho & 15; return 8 * (i >> 2) + 4 * n + (i & 3); }

struct Unit { int pm, pn, half; };
struct Gemm { const bf16_t* A; const bf16_t* Bt; int M, N, K; };

struct StaticOrder {
    int nM, nN, nwg, G, c;
    __host__ __device__ __forceinline__ void init(int M, int N, int G_, int c_) { nM = M / BM; nN = N / BM; nwg = nM * nN; G = G_; c = c_; }
    __host__ __device__ __forceinline__ bool next(int i, Unit& u) const {
        const long L = (long)i * G + c; if (L >= nwg) return false;
        int wgid = (int)L; { const int q = nwg / NXCD, r = nwg % NXCD, xcd = wgid % NXCD, off = wgid / NXCD; wgid = (xcd < r ? xcd * (q + 1) : r * (q + 1) + (xcd - r) * q) + off; }
        const int nig = WGM * nN, gid = wgid / nig, fm = gid * WGM, gsz = (nM - fm) < WGM ? (nM - fm) : WGM;
        u.pm = fm + ((wgid % nig) % gsz); u.pn = (wgid % nig) / gsz; u.half = 0; return true;
    }
    __device__ __forceinline__ void a_ready(const Unit&) const {}
    __device__ __forceinline__ void done(const Unit&) const {}
};
struct HalfTailOrder : StaticOrder {
    bool use_half;
    __host__ __device__ __forceinline__ bool next(int i, Unit& u) const {
        const int nfr = nwg / G, rem = nwg - nfr * G;
        if (!use_half || rem == 0 || 2 * rem > G || (G & 15) != 0) return StaticOrder::next(i, u);
        if (i < nfr) return StaticOrder::next(i, u);
        if (i > nfr) return false;
        const int cc = (c & 7) | ((c >> 4) << 3), hs = (c >> 3) & 1;
        if (cc >= rem) return false;
        StaticOrder T = *this; T.c = cc;
        T.next(nfr, u); u.half = 1 + hs; return true;
    }
};
__device__ __forceinline__ unsigned cvt_pk_bf16(float lo, float hi) { unsigned r; asm volatile("v_cvt_pk_bf16_f32 %0, %1, %2" : "=v"(r) : "v"(lo), "v"(hi)); return r; }
typedef float f32x2 __attribute__((ext_vector_type(2)));
template <class Epi, class Sched, bool ALIGN_EPI = false, bool SP2 = false, bool HALFU = false>
__device__ __forceinline__ void gemm_phase(PG8_LAS unsigned char* lds, const Gemm g, const Sched& S, const Epi& E, const int wv) {
    int tid = tid_of(wv);
    int wid_ = wv; asm volatile("" : "+s"(wid_)); const int wid = wid_, lane = tid & 63, wr = wid >> 2, wc = wid & 3, fr = lane & 15, fq = lane >> 4;
    int K = g.K; asm volatile("" : "+s"(K)); const int nt = K / BK;
    unsigned voffA[2], voffB[2];
#pragma unroll
    for (int i = 0; i < 2; ++i) { int R, C; stage_rc(tid * 16 + i * 8192, R, C); const int Rb = Epi::PERM ? ((R & ~31) + perm32(R & 31)) : R;
        voffA[i] = (unsigned)(R * K + C) * 2u; voffB[i] = (unsigned)(Rb * K + C) * 2u; }
    const size_t kstep = (size_t)(BK * 2);
    const size_t hstep = (size_t)HALF * K * 2;
    const size_t tstep = 2 * hstep;
    const unsigned ldsw = (unsigned)wid * 1024u;
    const int aoff = lds_byte(wr * 64 + fr, fq * 8), boff = lds_byte(wc * 32 + fr, fq * 8);
#define PG8_SA(b, h) (((b) * 2 + (h)) * HTB)
#define PG8_SB(b, h) ((4 + (b) * 2 + (h)) * HTB)
#define PG8_STAGE(bufoff, gbase, voff) do { _Pragma("unroll") for (int _i = 0; _i < 2; ++_i) \
        __builtin_amdgcn_global_load_lds((const unsigned*)((const char*)(gbase) + (voff)[_i]), (PG8_LAS unsigned*)(lds + (bufoff) + ldsw + _i * 8192), 16, 0, 0); } while (0)
#define PG8_LDA(dst, b, h) do { _Pragma("unroll") for (int m = 0; m < 4; ++m) _Pragma("unroll") for (int k = 0; k < 2; ++k) dst[m][k] = *(const PG8_LAS bf16x8*)(lds + PG8_SA(b, h) + aoff + m * 2048 + k * 1024); } while (0)
#define PG8_LDB(dst, b, h) do { _Pragma("unroll") for (int n = 0; n < 2; ++n) _Pragma("unroll") for (int k = 0; k < 2; ++k) dst[n][k] = *(const PG8_LAS bf16x8*)(lds + PG8_SB(b, h) + boff + n * 2048 + k * 1024); } while (0)
#define PG8_MMA(ai, bj, At, Bt) do { __builtin_amdgcn_s_setprio(1); _Pragma("unroll") for (int m = 0; m < 4; ++m) _Pragma("unroll") for (int n = 0; n < 2; ++n) _Pragma("unroll") for (int k = 0; k < 2; ++k) \
        acc[ai][bj][m][n] = __builtin_amdgcn_mfma_f32_16x16x32_bf16(Bt[n][k], At[m][k], acc[ai][bj][m][n], 0, 0, 0); __builtin_amdgcn_s_setprio(0); } while (0)
#define PG8_WAIT_V(n) asm volatile("s_waitcnt vmcnt(" #n ")" ::: "memory")
#define PG8_WAIT_L(n) asm volatile("s_waitcnt lgkmcnt(" #n ")" ::: "memory")
#define PG8_BAR __builtin_amdgcn_s_barrier()
#define PG8_SCHED __builtin_amdgcn_sched_barrier(0)
    Unit cur, nxt; int ui = 0;
    if (!S.next(0, cur)) return;
    f32x4 acc[2][2][4][2];
    u32x4 ini[2][4][2];
    if constexpr (Epi::PRE) E.pre_load(ini, cur, tid);
    if constexpr (Epi::INIT_ACC) E.init_load(ini, cur, wr, wc, fr, fq);
    else {
#pragma unroll
    for (int a = 0; a < 2; ++a)
#pragma unroll
        for (int b = 0; b < 2; ++b)
#pragma unroll
            for (int m = 0; m < 4; ++m)
#pragma unroll
                for (int n = 0; n < 2; ++n) acc[a][b][m][n] = (f32x4){0.f, 0.f, 0.f, 0.f};
    }
    bf16x8 At[4][2], B0[2][2], B1[2][2];
    const char* cA = (const char*)g.A + (size_t)cur.pm * tstep + (cur.half == 2 ? hstep : (size_t)0); bool full = HALFU ? (cur.half == 0) : true; const char* cB = (const char*)g.Bt + (size_t)cur.pn * tstep;
    S.a_ready(cur);
    if constexpr (SP2) {
        PG8_STAGE(PG8_SB(0, 0), cB, voffB); PG8_STAGE(PG8_SB(0, 1), cB + hstep, voffB); PG8_STAGE(PG8_SA(0, 0), cA, voffA); PG8_STAGE(PG8_SA(0, 1), cA + hstep, voffA);
        if constexpr (Epi::PRE) E.pre_finish(ini, tid);
        if constexpr (Epi::INIT_ACC) E.init_finish(acc, ini);
        if (wr == 1) PG8_BAR;
        PG8_WAIT_V(2); PG8_BAR;
        PG8_STAGE(PG8_SB(1, 0), cB + kstep, voffB); PG8_STAGE(PG8_SA(1, 0), cA + kstep, voffA); PG8_STAGE(PG8_SB(1, 1), cB + hstep + kstep, voffB);
        PG8_WAIT_V(6); PG8_BAR;
    } else {
        PG8_STAGE(PG8_SB(0, 0), cB, voffB); PG8_STAGE(PG8_SA(0, 0), cA, voffA); PG8_STAGE(PG8_SB(0, 1), cB + hstep, voffB); PG8_STAGE(PG8_SA(0, 1), cA + hstep, voffA);
        if (wr == 1) PG8_BAR;
        PG8_WAIT_V(4); PG8_BAR;
        PG8_STAGE(PG8_SB(1, 0), cB + kstep, voffB); PG8_STAGE(PG8_SA(1, 0), cA + kstep, voffA); PG8_STAGE(PG8_SB(1, 1), cB + hstep + kstep, voffB);
        PG8_WAIT_V(6); PG8_BAR;
    }
    for (;;) {
        const bool has_next = S.next(ui + 1, nxt);
        const char* nA = has_next ? (const char*)g.A + (size_t)nxt.pm * tstep + (nxt.half == 2 ? hstep : (size_t)0) : cA; const char* nB = has_next ? (const char*)g.Bt + (size_t)nxt.pn * tstep : cB;
        for (int t = 0; t < nt; t += 2) {
            const bool last = (t == nt - 2);
            const char* a1 = cA + (size_t)(t + 1) * kstep;
            const char* a2 = last ? nA : cA + (size_t)(t + 2) * kstep; const char* b2 = last ? nB : cB + (size_t)(t + 2) * kstep;
            const char* a3 = a2 + kstep; const char* b3 = b2 + kstep;
            if (last && has_next) S.a_ready(nxt);
            if constexpr (SP2) {
            PG8_LDB(B0, 0, 0); PG8_LDB(B1, 0, 1); PG8_SCHED; PG8_LDA(At, 0, 0); PG8_STAGE(PG8_SA(1, 1), a1 + hstep, voffA);
            PG8_WAIT_V(8); PG8_WAIT_L(0); PG8_BAR; PG8_MMA(0, 0, At, B0); PG8_MMA(0, 1, At, B1); PG8_BAR; PG8_SCHED;
            if (!HALFU || full) PG8_LDA(At, 0, 1); PG8_STAGE(PG8_SB(0, 0), b2, voffB); PG8_STAGE(PG8_SB(0, 1), b2 + hstep, voffB); PG8_STAGE(PG8_SA(0, 0), a2, voffA);
            PG8_WAIT_V(8); PG8_WAIT_L(0); PG8_BAR; if (!HALFU || full) { PG8_MMA(1, 0, At, B0); PG8_MMA(1, 1, At, B1); } PG8_BAR; PG8_SCHED;
            PG8_LDB(B0, 1, 0); PG8_LDB(B1, 1, 1); PG8_SCHED; PG8_LDA(At, 1, 0); PG8_STAGE(PG8_SA(0, 1), a2 + hstep, voffA);
            PG8_WAIT_V(8); PG8_WAIT_L(0); PG8_BAR; PG8_MMA(0, 0, At, B0); PG8_MMA(0, 1, At, B1); PG8_BAR; PG8_SCHED;
            if (!HALFU || full) PG8_LDA(At, 1, 1); PG8_STAGE(PG8_SB(1, 0), b3, voffB); PG8_STAGE(PG8_SB(1, 1), b3 + hstep, voffB); PG8_STAGE(PG8_SA(1, 0), a3, voffA);
            PG8_WAIT_V(8); PG8_WAIT_L(0); PG8_BAR; if (!HALFU || full) { PG8_MMA(1, 0, At, B0); PG8_MMA(1, 1, At, B1); } PG8_BAR; PG8_SCHED;
            } else {
            PG8_LDB(B0, 0, 0); PG8_SCHED; PG8_LDA(At, 0, 0); PG8_STAGE(PG8_SA(1, 1), a1 + hstep, voffA);
            PG8_WAIT_L(8); PG8_BAR; PG8_WAIT_L(0); PG8_MMA(0, 0, At, B0); PG8_BAR; PG8_SCHED;
            PG8_LDB(B1, 0, 1); PG8_STAGE(PG8_SB(0, 0), b2, voffB);
            PG8_BAR; PG8_WAIT_L(0); PG8_MMA(0, 1, At, B1); PG8_BAR;
            PG8_LDA(At, 0, 1); PG8_STAGE(PG8_SA(0, 0), a2, voffA);
            PG8_BAR; PG8_WAIT_L(0); PG8_MMA(1, 0, At, B0); PG8_BAR; PG8_SCHED;
            PG8_STAGE(PG8_SB(0, 1), b2 + hstep, voffB);
            PG8_WAIT_V(6); PG8_BAR; PG8_MMA(1, 1, At, B1); PG8_BAR;
            PG8_LDB(B0, 1, 0); PG8_SCHED; PG8_LDA(At, 1, 0); PG8_STAGE(PG8_SA(0, 1), a2 + hstep, voffA);
            PG8_WAIT_L(8); PG8_BAR; PG8_WAIT_L(0); PG8_MMA(0, 0, At, B0); PG8_BAR; PG8_SCHED;
            PG8_LDB(B1, 1, 1); PG8_STAGE(PG8_SB(1, 0), b3, voffB);
            PG8_BAR; PG8_WAIT_L(0); PG8_MMA(0, 1, At, B1); PG8_BAR;
            PG8_LDA(At, 1, 1); PG8_STAGE(PG8_SA(1, 0), a3, voffA);
            PG8_BAR; PG8_WAIT_L(0); PG8_MMA(1, 0, At, B0); PG8_BAR; PG8_SCHED;
            PG8_STAGE(PG8_SB(1, 1), b3 + hstep, voffB);
            PG8_WAIT_V(6); PG8_BAR; PG8_MMA(1, 1, At, B1); PG8_BAR;
            }
        }
        if constexpr (ALIGN_EPI) { if (wr == 0) PG8_BAR; }
        if constexpr (!Epi::AFTER_DRAIN) { E(acc, cur, wr, wc, fr, fq); S.done(cur); }
        if (!has_next) break;
#pragma unroll
        for (int a = 0; a < 2; ++a)
#pragma unroll
            for (int b = 0; b < 2; ++b)
#pragma unroll
                for (int m = 0; m < 4; ++m)
#pragma unroll
                    for (int n = 0; n < 2; ++n) acc[a][b][m][n] = (f32x4){0.f, 0.f, 0.f, 0.f};
        if constexpr (Epi::INIT_ACC) { E.init_load(ini, nxt, wr, wc, fr, fq); E.init_finish(acc, ini); }
        cur = nxt; cA = nA; cB = nB; ++ui; full = HALFU ? (cur.half == 0) : true;
        if constexpr (ALIGN_EPI) { if (wr == 1) PG8_BAR; }
    }
    PG8_WAIT_V(0);
    if constexpr (!ALIGN_EPI) { if (wr == 0) PG8_BAR; }
    PG8_BAR;
    if constexpr (Epi::AFTER_DRAIN) { E.fused(acc, cur, wr, wc, fr, fq, lds, wid, lane); S.done(cur); }
#undef PG8_SA
#undef PG8_SB
#undef PG8_STAGE
#undef PG8_LDA
#undef PG8_LDB
#undef PG8_MMA
#undef PG8_WAIT_V
#undef PG8_WAIT_L
#undef PG8_BAR
#undef PG8_SCHED
}
}
namespace pg8 {
typedef float f32x2v __attribute__((ext_vector_type(2)));
constexpr float RMS_EPS = 1e-6f;
constexpr float LOG2E = 1.4426950408889634f;
__device__ __forceinline__ unsigned pkbf(float lo, float hi) { typedef __bf16 bf2 __attribute__((ext_vector_type(2))); f32x2v v = {lo, hi}; bf2 b = __builtin_convertvector(v, bf2); return __builtin_bit_cast(unsigned, b); }
__device__ __forceinline__ u32x4 pk8(const f32x4 a, const f32x4 b) { u32x4 w; w.x = pkbf(a[0], a[1]); w.y = pkbf(a[2], a[3]); w.z = pkbf(b[0], b[1]); w.w = pkbf(b[2], b[3]); return w; }
__device__ __forceinline__ float sum4sq(const f32x4 a) { return (a[0] * a[0] + a[1] * a[1]) + (a[2] * a[2] + a[3] * a[3]); }
__device__ __forceinline__ float red_fq(float s) { s += __shfl_xor(s, 16); s += __shfl_xor(s, 32); return s; }
__device__ __forceinline__ void load_rstd16(const float* ssp, int row0, int fq, float (&rs)[2][4]) {
    f32x4 v[2][4];
#pragma unroll
    for (int ai = 0; ai < 2; ++ai)
#pragma unroll
        for (int m = 0; m < 4; ++m) v[ai][m] = *(const f32x4*)(ssp + (size_t)(row0 + ai * HALF + m * 16) * 16 + 4 * fq);
    asm volatile("" : "+v"(v[0][0]), "+v"(v[0][1]), "+v"(v[0][2]), "+v"(v[0][3]), "+v"(v[1][0]), "+v"(v[1][1]), "+v"(v[1][2]), "+v"(v[1][3]));
#pragma unroll
    for (int ai = 0; ai < 2; ++ai)
#pragma unroll
        for (int m = 0; m < 4; ++m) { const float s = red_fq((v[ai][m][0] + v[ai][m][1]) + (v[ai][m][2] + v[ai][m][3])); rs[ai][m] = rsqrtf(s * (1.0f / 1024.0f) + RMS_EPS); }
}
__device__ __forceinline__ void load_rstd4(const float* part, int row0, float inv_n, float (&rs)[2][4]) {
    f32x4 v[2][4];
#pragma unroll
    for (int ai = 0; ai < 2; ++ai)
#pragma unroll
        for (int m = 0; m < 4; ++m) v[ai][m] = *(const f32x4*)(part + (size_t)(row0 + ai * HALF + m * 16) * 4);
    asm volatile("" : "+v"(v[0][0]), "+v"(v[0][1]), "+v"(v[0][2]), "+v"(v[0][3]), "+v"(v[1][0]), "+v"(v[1][1]), "+v"(v[1][2]), "+v"(v[1][3]));
#pragma unroll
    for (int ai = 0; ai < 2; ++ai)
#pragma unroll
        for (int m = 0; m < 4; ++m) rs[ai][m] = rsqrtf(((v[ai][m][0] + v[ai][m][1]) + (v[ai][m][2] + v[ai][m][3])) * inv_n + RMS_EPS);
}
__device__ __forceinline__ float rstd16(const float* ssp, int r, int fq) { const f32x4 v = *(const f32x4*)(ssp + (size_t)r * 16 + 4 * fq); const float s = red_fq((v[0] + v[1]) + (v[2] + v[3])); return rsqrtf(s * (1.0f / 1024.0f) + RMS_EPS); }
__device__ __forceinline__ float rstd4(const float* part, int r, float inv_n) { const f32x4 v = *(const f32x4*)(part + (size_t)r * 4); return rsqrtf(((v[0] + v[1]) + (v[2] + v[3])) * inv_n + RMS_EPS); }
__device__ __forceinline__ void tbl_load16(u32x4 (&ini)[2][4][2], const float* ssp, int prow, int tid) {
    if (tid < 256) { const u32x4* sp = (const u32x4*)(ssp + (size_t)(prow + tid) * 16); ini[0][0][0] = sp[0]; ini[0][0][1] = sp[1]; ini[0][1][0] = sp[2]; ini[0][1][1] = sp[3]; } }
__device__ __forceinline__ void tbl_fin16(const u32x4 (&ini)[2][4][2], PG8_LAS float* rsl, int tid) {
    if (tid < 256) { const f32x4 s0 = __builtin_bit_cast(f32x4, ini[0][0][0]), s1 = __builtin_bit_cast(f32x4, ini[0][0][1]), s2 = __builtin_bit_cast(f32x4, ini[0][1][0]), s3 = __builtin_bit_cast(f32x4, ini[0][1][1]);
        const float sm = ((s0[0] + s0[1]) + (s0[2] + s0[3])) + ((s1[0] + s1[1]) + (s1[2] + s1[3])) + ((s2[0] + s2[1]) + (s2[2] + s2[3])) + ((s3[0] + s3[1]) + (s3[2] + s3[3]));
        rsl[tid] = rsqrtf(sm * (1.0f / 1024.0f) + RMS_EPS); } }
__device__ __forceinline__ void tbl_load4(u32x4 (&ini)[2][4][2], const float* part, int prow, int tid) { if (tid < 256) ini[0][0][0] = *(const u32x4*)(part + (size_t)(prow + tid) * 4); }
__device__ __forceinline__ void tbl_fin4(const u32x4 (&ini)[2][4][2], PG8_LAS float* rsl, float inv_n, int tid) {
    if (tid < 256) { const f32x4 v = __builtin_bit_cast(f32x4, ini[0][0][0]); rsl[tid] = rsqrtf(((v[0] + v[1]) + (v[2] + v[3])) * inv_n + RMS_EPS); } }
__device__ __forceinline__ void tbl_get(const PG8_LAS float* rsl, int rl0, float (&rs)[2][4]) {
#pragma unroll
    for (int ai = 0; ai < 2; ++ai)
#pragma unroll
        for (int m = 0; m < 4; ++m) rs[ai][m] = rsl[(rl0 + ai * HALF + m * 16) & 255]; }
struct EpiSwiGLU {
    static constexpr bool PERM = true, AFTER_DRAIN = false, INIT_ACC = false, PRE = true;
    bf16_t* H; int ldh; PG8_LAS float* rsl; const float* ssp;
    __device__ __forceinline__ void pre_load(u32x4 (&ini)[2][4][2], const Unit& u, int tid) const { tbl_load16(ini, ssp, u.pm * BM, tid); }
    __device__ __forceinline__ void pre_finish(const u32x4 (&ini)[2][4][2], int tid) const { tbl_fin16(ini, rsl, tid); }
    __device__ __forceinline__ void operator()(const f32x4 (&acc)[2][2][4][2], const Unit& u, int wr, int wc, int fr, int fq) const {
        asm volatile("" : "+v"(fr), "+v"(fq));
        const int nai = u.half ? 1 : 2; const int row0 = u.pm * BM + (u.half == 2 ? HALF : 0) + wr * 64 + fr, col0 = u.pn * HALF + wc * 32 + 8 * fq;
        const int rl0 = (u.half == 2 ? HALF : 0) + wr * 64 + fr;
        const __amdgpu_buffer_rsrc_t hrs = __builtin_amdgcn_make_buffer_rsrc((void*)H, 0, 0x7ffffff0, 0x00020000);
#pragma unroll
        for (int ai = 0; ai < 2; ++ai) if (ai < nai)
#pragma unroll
            for (int m = 0; m < 4; ++m) { const float r = rsl[rl0 + ai * HALF + m * 16]; f32x4 a[2]; const float c = -LOG2E * r, r2 = r * r;
#pragma unroll
                for (int n = 0; n < 2; ++n) { const f32x4 G = acc[ai][0][m][n], t = G * c, gu = G * acc[ai][1][m][n]; f32x4 ex;
#pragma unroll
                    for (int e = 0; e < 4; ++e) ex[e] = __builtin_amdgcn_exp2f(t[e]);
                    const f32x4 d = ex + 1.0f; f32x4 q;
#pragma unroll
                    for (int e = 0; e < 4; ++e) q[e] = __builtin_amdgcn_rcpf(d[e]);
                    a[n] = (gu * q) * r2; }
                __builtin_amdgcn_raw_buffer_store_b128(pk8(a[0], a[1]), hrs, (unsigned)(((row0 + ai * HALF + m * 16) * ldh + col0) * 2), 0, 16); }
    }
};
struct EpiResid {
    static constexpr bool PERM = true, AFTER_DRAIN = false, INIT_ACC = true, PRE = false;
    const float* R; float* X; bf16_t* XB; float* ssp; float alpha; bool wx;
    __device__ __forceinline__ void init_load(u32x4 (&ini)[2][4][2], const Unit& u, int wr, int wc, int fr, int fq) const {
        asm volatile("" : "+v"(fr), "+v"(fq));
        const int row0 = u.pm * BM + wr * 64 + fr, col0 = u.pn * BM + wc * 32 + 8 * fq;
#pragma unroll
        for (int ai = 0; ai < 2; ++ai)
#pragma unroll
            for (int m = 0; m < 4; ++m)
#pragma unroll
                for (int bj = 0; bj < 2; ++bj) ini[ai][m][bj] = *(const u32x4*)(XB + (size_t)(row0 + ai * HALF + m * 16) * 1024 + col0 + bj * HALF);
    }
    __device__ __forceinline__ void init_finish(f32x4 (&acc)[2][2][4][2], const u32x4 (&ini)[2][4][2]) const {
        const float ia = alpha != 0.f ? 1.0f / alpha : 0.f;
#pragma unroll
        for (int ai = 0; ai < 2; ++ai)
#pragma unroll
            for (int m = 0; m < 4; ++m)
#pragma unroll
                for (int bj = 0; bj < 2; ++bj) { const u32x4 q = ini[ai][m][bj];
                    acc[ai][bj][m][0] = (f32x4){__uint_as_float(q.x << 16), __uint_as_float(q.x & 0xffff0000u), __uint_as_float(q.y << 16), __uint_as_float(q.y & 0xffff0000u)} * ia;
                    acc[ai][bj][m][1] = (f32x4){__uint_as_float(q.z << 16), __uint_as_float(q.z & 0xffff0000u), __uint_as_float(q.w << 16), __uint_as_float(q.w & 0xffff0000u)} * ia; }
    }
    __device__ __forceinline__ void operator()(const f32x4 (&acc)[2][2][4][2], const Unit& u, int wr, int wc, int fr, int fq) const {
        asm volatile("" : "+v"(fr), "+v"(fq));
        const int row0 = u.pm * BM + wr * 64 + fr, col0 = u.pn * BM + wc * 32 + 8 * fq;
#pragma unroll
        for (int ai = 0; ai < 2; ++ai)
#pragma unroll
            for (int m = 0; m < 4; ++m) { const int r = row0 + ai * HALF + m * 16; float ss = 0.f;
#pragma unroll
                for (int bj = 0; bj < 2; ++bj) { const size_t off = (size_t)r * 1024 + col0 + bj * HALF;
                    const f32x4 x0 = acc[ai][bj][m][0] * alpha, x1 = acc[ai][bj][m][1] * alpha;
                    if (wx) { asm volatile("global_store_dwordx4 %0, %1, off sc1" :: "v"(X + off), "v"(x0) : "memory"); asm volatile("global_store_dwordx4 %0, %1, off offset:16 sc1" :: "v"(X + off), "v"(x1) : "memory"); }
                    else { *(u32x4*)(XB + off) = pk8(x0, x1); ss += sum4sq(x0) + sum4sq(x1); } }
                if (!wx) { ss = red_fq(ss); if (fq == 0) ssp[(size_t)r * 16 + u.pn * 4 + wc] = ss; } }
    }
};
struct EpiQKV {
    static constexpr bool PERM = true, AFTER_DRAIN = false, INIT_ACC = false, PRE = false;
    bf16_t *Q, *K, *V; const float* ssp; const float *qg, *kg; float qsc; PG8_LAS float* rsl;
    __device__ __forceinline__ void pre_load(u32x4 (&ini)[2][4][2], const Unit& u, int tid) const { tbl_load16(ini, ssp, u.pm * BM, tid); }
    __device__ __forceinline__ void pre_finish(const u32x4 (&ini)[2][4][2], int tid) const { tbl_fin16(ini, rsl, tid); }
    __device__ __forceinline__ void operator()(const f32x4 (&acc)[2][2][4][2], const Unit& u, int wr, int wc, int fr, int fq) const {
        asm volatile("" : "+v"(fr), "+v"(fq));
        const int row0 = u.pm * BM + wr * 64 + fr;
        float rs[2][4]; load_rstd16(ssp, row0, fq, rs);
        const bool isq = u.pn < 4, isv = (!isq) && wc >= 2;
        bf16_t* base = isq ? Q + (u.pn * 4 + wc) * 64 : (isv ? V + (wc - 2) * 64 : K + wc * 64); const int ld = isq ? 1024 : 128;
        const float* gp = isq ? qg : kg; const float gs = isq ? qsc : 1.0f;
        f32x4 g[2][2];
#pragma unroll
        for (int bj = 0; bj < 2; ++bj)
#pragma unroll
            for (int n = 0; n < 2; ++n) g[bj][n] = *(const f32x4*)(gp + 32 * bj + 8 * fq + 4 * n) * gs;
#pragma unroll
        for (int ai = 0; ai < 2; ++ai)
#pragma unroll
            for (int m = 0; m < 4; ++m) { const int r = row0 + ai * HALF + m * 16; const float rx = rs[ai][m]; f32x4 v[2][2]; float ss = 0.f;
#pragma unroll
                for (int bj = 0; bj < 2; ++bj)
#pragma unroll
                    for (int n = 0; n < 2; ++n) { v[bj][n] = acc[ai][bj][m][n] * rx; ss += sum4sq(v[bj][n]); }
                ss = red_fq(ss); const float rn = rsqrtf(ss * (1.0f / 64.0f) + RMS_EPS);
#pragma unroll
                for (int bj = 0; bj < 2; ++bj) { f32x4 a = v[bj][0], b = v[bj][1]; if (!isv) { a = a * g[bj][0] * rn; b = b * g[bj][1] * rn; }
                    *(u32x4*)(base + (size_t)r * ld + 32 * bj + 8 * fq) = pk8(a, b); } }
    }
};
__device__ __forceinline__ double rope_invf(int i) {
    switch (i) { case 0: return 1.0; case 1: return 0.5623413251903491; case 2: return 0.31622776601683794; case 3: return 0.1778279410038923; case 4: return 0.1; case 5: return 0.05623413251903491;
        case 6: return 0.03162277660168379; case 7: return 0.01778279410038923; case 8: return 0.01; case 9: return 0.005623413251903491; case 10: return 0.0031622776601683794; case 11: return 0.0017782794100389228;
        case 12: return 0.001; case 13: return 0.0005623413251903491; case 14: return 0.00031622776601683794; default: return 0.00017782794100389227; }
}
__device__ __forceinline__ void rope_cs(float posf, int i, float& cs, float& sn) {
    const float ang = posf * (float)rope_invf(i);
    double rev = (double)ang * 0.15915494309189535; rev -= __builtin_rint(rev);
    const float rf = (float)rev; cs = __builtin_amdgcn_cosf(rf); sn = __builtin_amdgcn_sinf(rf);
}
struct EpiBIn {
    static constexpr bool PERM = true, AFTER_DRAIN = false, INIT_ACC = false, PRE = false;
    bf16_t *Cq, *Ckv; float *ssq, *sskv, *ssr, *KR; const float* ssp; const float* cst  ; const float* kg; PG8_LAS float* rsl;
    __device__ __forceinline__ void pre_load(u32x4 (&ini)[2][4][2], const Unit& u, int tid) const { tbl_load16(ini, ssp, u.pm * BM, tid); }
    __device__ __forceinline__ void pre_finish(const u32x4 (&ini)[2][4][2], int tid) const { tbl_fin16(ini, rsl, tid); }
    __device__ __forceinline__ void operator()(const f32x4 (&acc)[2][2][4][2], const Unit& u, int wr, int wc, int fr, int fq) const {
        asm volatile("" : "+v"(fr), "+v"(fq));
        const int nai = u.half ? 1 : 2; const int row0 = u.pm * BM + (u.half == 2 ? HALF : 0) + wr * 64 + fr;
        float rs[2][4]; load_rstd16(ssp, row0, fq, rs);
        if (u.pn == 0) {
#pragma unroll
            for (int ai = 0; ai < 2; ++ai) if (ai < nai)
#pragma unroll
                for (int m = 0; m < 4; ++m) { const int r = row0 + ai * HALF + m * 16; const float rx = rs[ai][m]; float ss = 0.f;
#pragma unroll
                    for (int bj = 0; bj < 2; ++bj) { const f32x4 a = acc[ai][bj][m][0] * rx, b = acc[ai][bj][m][1] * rx; ss += sum4sq(a) + sum4sq(b);
                        *(u32x4*)(Cq + (size_t)r * 256 + bj * HALF + wc * 32 + 8 * fq) = pk8(a, b); }
                    ss = red_fq(ss); if (fq == 0) ssq[(size_t)r * 4 + wc] = ss; }
        } else {
#pragma unroll
            for (int ai = 0; ai < 2; ++ai) if (ai < nai)
#pragma unroll
                for (int m = 0; m < 4; ++m) { const int r = row0 + ai * HALF + m * 16; const float rx = rs[ai][m];
                    const f32x4 a = acc[ai][0][m][0] * rx, b = acc[ai][0][m][1] * rx; float ss = red_fq(sum4sq(a) + sum4sq(b));
                    *(u32x4*)(Ckv + (size_t)r * 128 + wc * 32 + 8 * fq) = pk8(a, b);
                    if (fq == 0) sskv[(size_t)r * 4 + wc] = ss; }
            if (wc == 0) {
                const f32x4 g1 = *(const f32x4*)(kg + 64 + 4 * fq), g2 = *(const f32x4*)(kg + 80 + 4 * fq);
#pragma unroll
                for (int ai = 0; ai < 2; ++ai) if (ai < nai) {
                    f32x4 cs[4], sn[4];
#pragma unroll
                    for (int m = 0; m < 4; ++m) { const int r = row0 + ai * HALF + m * 16; cs[m] = *(const f32x4*)(cst + (size_t)r * 32 + 4 * fq); sn[m] = *(const f32x4*)(cst + (size_t)r * 32 + 16 + 4 * fq); }
                    asm volatile("" ::: "memory");
#pragma unroll
                    for (int m = 0; m < 4; ++m) { const int r = row0 + ai * HALF + m * 16; const float rx = rs[ai][m];
                        f32x4 t1 = acc[ai][1][m][0] * rx, t2 = acc[ai][1][m][1] * rx;
                        const float s2 = red_fq(sum4sq(t1) + sum4sq(t2)); if (fq == 0) ssr[r] = s2;
                        t1 = t1 * g1; t2 = t2 * g2;
                        const f32x4 o1 = t1 * cs[m] - t2 * sn[m], o2 = t2 * cs[m] + t1 * sn[m];
                        *(f32x4*)(KR + (size_t)r * 32 + 4 * fq) = o1; *(f32x4*)(KR + (size_t)r * 32 + 16 + 4 * fq) = o2; }
                    asm volatile("" ::: "memory"); } }
        }
    }
};
struct EpiUQ {
    static constexpr bool PERM = true, AFTER_DRAIN = false, INIT_ACC = false, PRE = true;
    bf16_t* QR; const float* ssq; PG8_LAS float* rsl;
    __device__ __forceinline__ void pre_load(u32x4 (&ini)[2][4][2], const Unit& u, int tid) const { tbl_load4(ini, ssq, u.pm * BM, tid); }
    __device__ __forceinline__ void pre_finish(const u32x4 (&ini)[2][4][2], int tid) const { tbl_fin4(ini, rsl, 1.0f / 256.0f, tid); }
    __device__ __forceinline__ void operator()(const f32x4 (&acc)[2][2][4][2], const Unit& u, int wr, int wc, int fr, int fq) const {
        asm volatile("" : "+v"(fr), "+v"(fq));
        const int nai = u.half ? 1 : 2; const int row0 = u.pm * BM + (u.half == 2 ? HALF : 0) + wr * 64 + fr, col0 = u.pn * BM + wc * 32 + 8 * fq;
        float rs[2][4]; tbl_get(rsl, (u.half == 2 ? HALF : 0) + wr * 64 + fr, rs);
#pragma unroll
        for (int ai = 0; ai < 2; ++ai) if (ai < nai)
#pragma unroll
            for (int m = 0; m < 4; ++m) { const int r = row0 + ai * HALF + m * 16; const float rx = rs[ai][m];
#pragma unroll
                for (int bj = 0; bj < 2; ++bj) *(u32x4*)(QR + (size_t)r * 1536 + col0 + bj * HALF) = pk8(acc[ai][bj][m][0] * rx, acc[ai][bj][m][1] * rx); }
    }
};
struct EpiUKV {
    static constexpr bool PERM = true, AFTER_DRAIN = false, INIT_ACC = false, PRE = true;
    bf16_t *KF, *VF; const float *sskv, *ssr, *KR; PG8_LAS float* rsl;
    __device__ __forceinline__ void pre_load(u32x4 (&ini)[2][4][2], const Unit& u, int tid) const { tbl_load4(ini, sskv, u.pm * BM, tid); }
    __device__ __forceinline__ void pre_finish(const u32x4 (&ini)[2][4][2], int tid) const { tbl_fin4(ini, rsl, 1.0f / 128.0f, tid); }
    __device__ __forceinline__ void operator()(const f32x4 (&acc)[2][2][4][2], const Unit& u, int wr, int wc, int fr, int fq) const {
        asm volatile("" : "+v"(fr), "+v"(fq));
        const int row0 = u.pm * BM + wr * 64 + fr;
        float rs[2][4]; tbl_get(rsl, wr * 64 + fr, rs);
        if (u.pn < 4) {
            const int head = u.pn * 4 + wc;
#pragma unroll
            for (int ai = 0; ai < 2; ++ai) {
                float sr[4]; f32x4 kr[4][2];
#pragma unroll
                for (int m = 0; m < 4; ++m) { const int r = row0 + ai * HALF + m * 16; sr[m] = ssr[r]; kr[m][0] = *(const f32x4*)(KR + (size_t)r * 32 + 8 * fq); kr[m][1] = *(const f32x4*)(KR + (size_t)r * 32 + 8 * fq + 4); }
                asm volatile("" ::: "memory");
#pragma unroll
                for (int m = 0; m < 4; ++m) { const int r = row0 + ai * HALF + m * 16; const float rx = rs[ai][m]; f32x4 v[2][2]; float ss = 0.f;
#pragma unroll
                    for (int bj = 0; bj < 2; ++bj)
#pragma unroll
                        for (int n = 0; n < 2; ++n) { v[bj][n] = acc[ai][bj][m][n] * rx; ss += sum4sq(v[bj][n]); }
                    ss = red_fq(ss) + sr[m]; const float rk = rsqrtf(ss * (1.0f / 96.0f) + RMS_EPS);
                    bf16_t* kp = KF + (size_t)r * 1536 + head * 96;
#pragma unroll
                    for (int bj = 0; bj < 2; ++bj) *(u32x4*)(kp + 32 * bj + 8 * fq) = pk8(v[bj][0] * rk, v[bj][1] * rk);
                    *(u32x4*)(kp + 64 + 8 * fq) = pk8(kr[m][0] * rk, kr[m][1] * rk); }
                asm volatile("" ::: "memory"); }
        } else {
            const int head = (u.pn - 4) * 4 + wc;
#pragma unroll
            for (int ai = 0; ai < 2; ++ai)
#pragma unroll
                for (int m = 0; m < 4; ++m) { const int r = row0 + ai * HALF + m * 16; const float rx = rs[ai][m];
#pragma unroll
                    for (int bj = 0; bj < 2; ++bj) *(u32x4*)(VF + (size_t)r * 1024 + head * 64 + 32 * bj + 8 * fq) = pk8(acc[ai][bj][m][0] * rx, acc[ai][bj][m][1] * rx); }
        }
    }
};
}
namespace att {
#define ALAS __attribute__((address_space(3)))
typedef unsigned short bf16_t;
typedef short bf16x8 __attribute__((ext_vector_type(8)));
typedef short s16x4 __attribute__((ext_vector_type(4)));
typedef float f32x16 __attribute__((ext_vector_type(16)));
typedef float f32x4 __attribute__((ext_vector_type(4)));
typedef unsigned u32x4 __attribute__((ext_vector_type(4)));
constexpr int SEQ = 2048;
constexpr float NEGBIG = -1e30f;
constexpr float LOG2E = 1.4426950408889634f;
__device__ __forceinline__ int crow(int r, int hi) { return (r & 3) + 8 * (r >> 2) + 4 * hi; }
__device__ __forceinline__ unsigned pkbf(float lo, float hi) { typedef float f2 __attribute__((ext_vector_type(2))); typedef __bf16 bf2 __attribute__((ext_vector_type(2))); f2 v = {lo, hi}; bf2 b = __builtin_convertvector(v, bf2); return __builtin_bit_cast(unsigned, b); }
__device__ __forceinline__ s16x4 vtr(const ALAS char* p) { typedef short v4i16_t __attribute__((ext_vector_type(4))); return __builtin_bit_cast(s16x4, __builtin_amdgcn_ds_read_tr16_b64_v4i16((ALAS v4i16_t*)p)); }
__device__ __forceinline__ bf16x8 pack8(const f32x16& p, int b) { u32x4 w; w.x = pkbf(p[b], p[b + 1]); w.y = pkbf(p[b + 2], p[b + 3]); w.z = pkbf(p[b + 4], p[b + 5]); w.w = pkbf(p[b + 6], p[b + 7]); return __builtin_bit_cast(bf16x8, w); }
__device__ __forceinline__ float xhalf_max(float v) { auto r = __builtin_amdgcn_permlane32_swap(__float_as_uint(v), __float_as_uint(v), false, false); return fmaxf(__uint_as_float(r[0]), __uint_as_float(r[1])); }
__device__ __forceinline__ float xhalf_sum(float v) { auto r = __builtin_amdgcn_permlane32_swap(__float_as_uint(v), __float_as_uint(v), false, false); return __uint_as_float(r[0]) + __uint_as_float(r[1]); }
#define LDSW() asm volatile("s_waitcnt lgkmcnt(0)" ::: "memory")
__device__ __forceinline__ void store_o(const f32x16 (&o)[2], float linv, ALAS float* wsf, ALAS bf16_t* stg, bf16_t* Og, int ldo, int lane) {
    const int r32 = lane & 31, hi = lane >> 5;
    LDSW(); if (hi == 0) wsf[r32] = linv; LDSW();
#pragma unroll
    for (int g = 0; g < 4; ++g) { const f32x4 f = *(const ALAS f32x4*)(wsf + 8 * g + 4 * hi);
#pragma unroll
        for (int e = 0; e < 4; ++e) { const int reg = 4 * g + e, orow = 8 * g + 4 * hi + e;
#pragma unroll
            for (int dh = 0; dh < 2; ++dh) { const unsigned w = pkbf(o[dh][reg] * f[e], 0.f); stg[orow * 64 + dh * 32 + r32] = (bf16_t)(w & 0xffffu); } } }
    LDSW();
#pragma unroll
    for (int i = 0; i < 4; ++i) { const int row = i * 8 + (lane >> 3), ch = lane & 7; const u32x4 v = *(const ALAS u32x4*)(stg + row * 64 + ch * 8); *(u32x4*)(Og + (size_t)row * ldo + ch * 8) = v; }
    LDSW();
}
__device__ __forceinline__ void rescale_o(f32x16 (&o)[2], float f, ALAS float* wsf, int lane) {
    const int r32 = lane & 31, hi = lane >> 5;
    LDSW(); if (hi == 0) wsf[r32] = f; LDSW();
#pragma unroll
    for (int g = 0; g < 4; ++g) { const f32x4 v = *(const ALAS f32x4*)(wsf + 8 * g + 4 * hi);
#pragma unroll
        for (int e = 0; e < 4; ++e) { o[0][4 * g + e] *= v[e]; o[1][4 * g + e] *= v[e]; } }
    LDSW();
}
__device__ __forceinline__ int t5_bucket(int n) {
    if (n < 16) return n;
    float t = __logf((float)n / 16.f); t = t / 2.0794415416798357f; t = t * 16.f;
    const int l = 16 + (int)t; return l < 31 ? l : 31;
}

constexpr int A_K = 0, A_V = 32768, A_POS = 65536, A_TAB = 66560, A_WSF = 70912, A_OST = 72960, A_END = A_OST + 8 * 4096;
struct AttnA { const bf16_t *Q, *K, *V; bf16_t* O; const int* pos; const float* rel_bias; const float* sinks; };
__device__ __forceinline__ void attnA_unit(ALAS char* lds, const AttnA& T, int b, int blk, int kvh, int wv) {
    int tid = tid_of(wv); const int lane = tid & 63, r32 = lane & 31, hi = lane >> 5; int w_ = wv; asm volatile("" : "+s"(w_)); const int w = w_;
    const int row0 = b * SEQ + blk * 128;
    __syncthreads();
    {
      u32x4 kv[4], vv[4];
#pragma unroll
      for (int it = 0; it < 4; ++it) { const int q = tid + 512 * it; const int key = q & 255, c = q >> 8; const int rr = (blk > 0 || key >= 128) ? row0 - 128 + key : row0;
          kv[it] = *(const u32x4*)(T.K + (size_t)rr * 128 + kvh * 64 + c * 8); }
#pragma unroll
      for (int it = 0; it < 4; ++it) { const int q = tid + 512 * it; const int dh = q >> 10, kg = (q >> 6) & 15, kin = (q >> 2) & 15, ch = q & 3, key = kg * 16 + kin; const int rr = (blk > 0 || key >= 128) ? row0 - 128 + key : row0;
          vv[it] = *(const u32x4*)(T.V + (size_t)rr * 128 + kvh * 64 + dh * 32 + ch * 8); }
      const int pidx = (blk > 0 || (tid & 255) >= 128) ? row0 - 128 + (tid & 255) : row0; const int pv = T.pos[pidx];
      float tb[3];
#pragma unroll
      for (int i = 0; i < 3; ++i) { int q = tid + 512 * i; q = q < 8 * 129 ? q : 8 * 129 - 1; const int g = q / 129, n = q - g * 129; tb[i] = T.rel_bias[t5_bucket(n) * 16 + kvh * 8 + g]; }
      asm volatile("" ::: "memory");
      const u32x4 z4 = (u32x4){0u, 0u, 0u, 0u};
#pragma unroll
      for (int it = 0; it < 4; ++it) { const int q = tid + 512 * it; const int key = q & 255, c = q >> 8; *(ALAS u32x4*)(lds + A_K + c * 4096 + key * 16) = (blk > 0 || key >= 128) ? kv[it] : z4; }
#pragma unroll
      for (int it = 0; it < 4; ++it) { const int q = tid + 512 * it; const int key = ((q >> 6) & 15) * 16 + ((q >> 2) & 15); *(ALAS u32x4*)(lds + A_V + q * 16) = (blk > 0 || key >= 128) ? vv[it] : z4; }
      if (tid < 256) ((ALAS int*)(lds + A_POS))[tid] = (blk > 0 || tid >= 128) ? pv : 0;
#pragma unroll
      for (int i = 0; i < 3; ++i) { const int q = tid + 512 * i; if (q < 8 * 129) { const int g = q / 129, n = q - g * 129; ((ALAS float*)(lds + A_TAB))[g * 136 + n] = tb[i] * LOG2E; } } }
    __syncthreads();
    const int h = kvh * 8 + w; const float sink2 = T.sinks[h] * LOG2E;
    const ALAS float* tab = (const ALAS float*)(lds + A_TAB) + w * 136; const ALAS int* posb = (const ALAS int*)(lds + A_POS);
    bool regular; { const int i0 = (blk > 0 ? 0 : 128) + (blk > 0 ? 4 : 2) * lane;
      bool ok = true;
#pragma unroll
      for (int e = 0; e < 4; ++e) { const int i = i0 + e; if ((blk > 0 || e < 2) && i + 1 < 256) ok = ok && (posb[i + 1] - posb[i] == 1); }
      regular = __all(ok); }
    const ALAS float* tabq = tab + (128 + r32 - 4 * hi);
    ALAS float* wsf = (ALAS float*)(lds + A_WSF) + w * 64; ALAS bf16_t* stg = (ALAS bf16_t*)(lds + A_OST + w * 4096);
    const ALAS char* vbase = lds + A_V + ((lane >> 4) & 1) * 32 + (lane & 3) * 8 + (4 * hi + ((lane & 15) >> 2)) * 64;
    bf16x8 qn[4];
#pragma unroll
    for (int d0 = 0; d0 < 4; ++d0) qn[d0] = *(const bf16x8*)(T.Q + (size_t)(row0 + r32) * 1024 + h * 64 + d0 * 16 + hi * 8);
    for (int qt = 0; qt < 4; ++qt) {
        bf16x8 qr[4];
#pragma unroll
        for (int d0 = 0; d0 < 4; ++d0) qr[d0] = qn[d0];
        { const int qnrow = row0 + 32 * (qt < 3 ? qt + 1 : 3) + r32;
#pragma unroll
          for (int d0 = 0; d0 < 4; ++d0) qn[d0] = *(const bf16x8*)(T.Q + (size_t)qnrow * 1024 + h * 64 + d0 * 16 + hi * 8); }
        const int posq = posb[128 + 32 * qt + r32];
        f32x16 s[5]; float mx = NEGBIG;
#pragma unroll
        for (int t5 = 0; t5 < 5; ++t5) { const int kt = qt + t5;
            if (blk == 0 && kt < 4) {
#pragma unroll
                for (int r = 0; r < 16; ++r) s[t5][r] = NEGBIG;
            } else {
                f32x16 a = {};
#pragma unroll
                for (int d0 = 0; d0 < 4; ++d0) { const bf16x8 kf = *(const ALAS bf16x8*)(lds + A_K + (2 * d0 + hi) * 4096 + (32 * kt + r32) * 16); a = __builtin_amdgcn_mfma_f32_32x32x16_bf16(kf, qr[d0], a, 0, 0, 0); }
                asm volatile("s_nop 15\n\ts_nop 7" : "+v"(a));
                if (regular) {
#pragma unroll
                    for (int r = 0; r < 16; ++r) { const int kl = crow(r, hi);
                        const bool valid = (t5 == 0) ? (kl > r32) : ((t5 == 4) ? (kl <= r32) : true);
                        float bv = tabq[-(32 * t5 + (r & 3) + 8 * (r >> 2))];
                        asm volatile("" : "+v"(bv));
                        const float v = valid ? a[r] + bv : NEGBIG; a[r] = v; mx = fmaxf(mx, v); }
                } else {
#pragma unroll
                    for (int r = 0; r < 16; ++r) { const int kl = crow(r, hi); int n = posq - posb[32 * kt + kl]; n = n < 0 ? 0 : (n > 128 ? 128 : n);
                        const bool valid = (t5 == 0) ? (kl > r32) : ((t5 == 4) ? (kl <= r32) : true);
                        const float v = valid ? a[r] + tab[n] : NEGBIG; a[r] = v; mx = fmaxf(mx, v); } }
                s[t5] = a; } }
        mx = fmaxf(xhalf_max(mx), sink2);
        float l = 0.f;
#pragma unroll
        for (int t5 = 0; t5 < 5; ++t5)
#pragma unroll
            for (int r = 0; r < 16; ++r) { const float p = __builtin_amdgcn_exp2f(s[t5][r] - mx); s[t5][r] = p; l += p; }
        l = xhalf_sum(l) + __builtin_amdgcn_exp2f(sink2 - mx);
        f32x16 o[2]; o[0] = f32x16{}; o[1] = f32x16{};
#pragma unroll
        for (int t5 = 0; t5 < 5; ++t5) { const int kt = qt + t5;
            if (!(blk == 0 && kt < 4)) {
#pragma unroll
                for (int ks = 0; ks < 2; ++ks) { const bf16x8 pa = pack8(s[t5], 8 * ks);
#pragma unroll
                    for (int dh = 0; dh < 2; ++dh) { const ALAS char* vp = vbase + dh * 16384 + (2 * kt + ks) * 1024; const s16x4 lo = vtr(vp), hh = vtr(vp + 512);
                        const bf16x8 vf = (bf16x8){lo[0], lo[1], lo[2], lo[3], hh[0], hh[1], hh[2], hh[3]};
                        o[dh] = __builtin_amdgcn_mfma_f32_32x32x16_bf16(pa, vf, o[dh], 0, 0, 0); } } } }
        store_o(o, 1.0f / l, wsf, stg, T.O + (size_t)(row0 + 32 * qt) * 1024 + h * 64, 1024, lane);
    }
}

constexpr int B_KSZ = 12288, B_VSZ = 8192, B_K = 0, B_V = 4 * B_KSZ, B_WSF = B_V + 3 * B_VSZ, B_OST = B_WSF + 2048, B_GQ = B_OST + 8 * 4096, B_END = B_GQ + 512;
struct AttnB { const bf16_t *QR, *KF, *VF; bf16_t* O; const float* cst; const float* qg; const float* kg; };
__device__ __forceinline__ void attnB_prime(ALAS char* lds, const AttnB& T, int wv) {
    int tid = tid_of(wv);
    if (tid < 96) { const float kgv = T.kg[tid < 64 ? tid : 0]; ((ALAS float*)(lds + B_GQ))[tid] = T.qg[tid] * (tid < 64 ? kgv : 1.0f); }
    __syncthreads();
}
__device__ __forceinline__ void glds16(const void* gsrc, unsigned lds_dst) { unsigned keep;
    asm volatile("s_mov_b32 %0, m0\n\ts_mov_b32 m0, %2\n\ts_nop 0\n\tglobal_load_lds_dwordx4 %1, off\n\ts_mov_b32 m0, %0" : "=&s"(keep) : "v"(gsrc), "s"(lds_dst) : "memory"); }
__device__ __forceinline__ void kload2(bf16x8* kf, const ALAS char* kp, int j, int dst) { kf[2 * dst] = *(const ALAS bf16x8*)(kp + j * 2048); kf[2 * dst + 1] = *(const ALAS bf16x8*)(kp + j * 2048 + 512); }
__device__ __forceinline__ void bmask(f32x16& p0, f32x16& p1, int jb, int qrel, int hi) {
    const float NEG = -INFINITY; const int kb = 64 * jb + 4 * hi;
#pragma unroll
    for (int r = 0; r < 16; ++r) { const int kv = kb + (r & 3) + 8 * (r >> 2); if (kv > qrel) p0[r] = NEG; if (kv + 32 > qrel) p1[r] = NEG; }
}
#define B_SBAR() __builtin_amdgcn_sched_barrier(0)
#define PIN(x) asm volatile("" : "+v"(x))
#define B_MFMA(a, b, c) __builtin_amdgcn_mfma_f32_32x32x16_bf16(a, b, c, 0, 0, 0)
#define B_WAIT_BAR(N) asm volatile("s_waitcnt vmcnt(" #N ") lgkmcnt(0)\n\ts_barrier" ::: "memory")
__device__ __forceinline__ void attnB_unit(ALAS char* lds, const AttnB& T, int b, int h, int qb, int wv, const bool pre, const bool nxt, const int nh, const int nqb, int& vs, bf16x8 (&qraw)[6]) {
    int tid = tid_of(wv); const int lane = tid & 63, r32 = lane & 31, hi = lane >> 5; int w_ = wv; asm volatile("" : "+s"(w_)); const int w = w_;
    const size_t rowb = (size_t)b * SEQ; const int q0 = qb * 256; const int NT = 4 * qb + 4;
    const unsigned lds0 = (unsigned)(uintptr_t)lds;
    const bf16_t* ksrc = T.KF + (rowb + lane) * 1536 + h * 96 + w * 8;
    const bf16_t* vsrc = T.VF + (rowb + 16 * (w & 3) + (lane >> 2)) * 1024 + h * 64 + (w >> 2) * 32 + (lane & 3) * 8;
    const unsigned kdst = lds0 + B_K + w * 1024, vdst = lds0 + B_V + w * 1024;
    const bool two = w < 4;
#define DMA_K(t, slot) do { glds16(ksrc + (size_t)(t) * 64 * 1536, (unsigned)__builtin_amdgcn_readfirstlane(kdst + (slot))); \
        if (two) glds16(ksrc + (size_t)(t) * 64 * 1536 + 64, (unsigned)__builtin_amdgcn_readfirstlane(kdst + (slot) + 8192)); } while (0)
#define DMA_V(t, slot) glds16(vsrc + (size_t)(t) * 64 * 1024, (unsigned)__builtin_amdgcn_readfirstlane(vdst + (slot)))
#define KSL(t) (((t) & 3) * B_KSZ)
    const ALAS char* kp0 = lds + B_K + hi * 1024 + r32 * 16;
    const ALAS char* vp0 = lds + B_V + ((lane >> 4) & 1) * 32 + (lane & 3) * 8 + (4 * hi + ((lane & 15) >> 2)) * 64;
    int sl_prev = vs * B_VSZ, sl_cur = sl_prev, sl_next = (vs == 2) ? 0 : sl_prev + B_VSZ;
    const int nvs = (vs + NT) % 3; vs = nvs;
    if (!pre) { asm volatile("s_waitcnt lgkmcnt(0)\n\ts_barrier" ::: "memory");
        DMA_K(0, 0); DMA_V(0, sl_cur); DMA_K(1, B_KSZ); DMA_K(2, 2 * B_KSZ);
#pragma unroll
        for (int d0 = 0; d0 < 6; ++d0) qraw[d0] = *(const bf16x8*)(T.QR + (size_t)((int)rowb + q0 + 32 * w + r32) * 1536 + h * 96 + d0 * 16 + hi * 8); }
    bf16x8 qr[6];
    { const int qrow = (int)rowb + q0 + 32 * w + r32; float qv[6][8]; float ss = 0.f;
#pragma unroll
      for (int d0 = 0; d0 < 6; ++d0) { const bf16x8 raw = qraw[d0];
#pragma unroll
          for (int j = 0; j < 8; ++j) { const float f = __uint_as_float(((unsigned)(unsigned short)raw[j]) << 16); qv[d0][j] = f; ss += f * f; } }
      ss = xhalf_sum(ss); const float rq = rsqrtf(ss * (1.0f / 96.0f) + 1e-6f);
#pragma unroll
      for (int d0 = 0; d0 < 6; ++d0) { const f32x4 g0 = *(const ALAS f32x4*)(lds + B_GQ + (d0 * 16 + hi * 8) * 4), g1 = *(const ALAS f32x4*)(lds + B_GQ + (d0 * 16 + hi * 8 + 4) * 4);
#pragma unroll
          for (int j = 0; j < 4; ++j) { qv[d0][j] *= rq * g0[j]; qv[d0][j + 4] *= rq * g1[j]; } }
      { const f32x4 c0 = *(const f32x4*)(T.cst + (size_t)qrow * 32 + 8 * hi), c1 = *(const f32x4*)(T.cst + (size_t)qrow * 32 + 8 * hi + 4), s0 = *(const f32x4*)(T.cst + (size_t)qrow * 32 + 16 + 8 * hi), s1 = *(const f32x4*)(T.cst + (size_t)qrow * 32 + 16 + 8 * hi + 4);
#pragma unroll
        for (int j = 0; j < 8; ++j) { const float cs = j < 4 ? c0[j & 3] : c1[j & 3], sn = j < 4 ? s0[j & 3] : s1[j & 3]; const float t1 = qv[4][j], t2 = qv[5][j]; qv[4][j] = t1 * cs - t2 * sn; qv[5][j] = t2 * cs + t1 * sn; } }
      const float sc = 0.10206207261596575f * LOG2E;
#pragma unroll
      for (int d0 = 0; d0 < 6; ++d0) { u32x4 wq; wq.x = pkbf(qv[d0][0] * sc, qv[d0][1] * sc); wq.y = pkbf(qv[d0][2] * sc, qv[d0][3] * sc); wq.z = pkbf(qv[d0][4] * sc, qv[d0][5] * sc); wq.w = pkbf(qv[d0][6] * sc, qv[d0][7] * sc); qr[d0] = __builtin_bit_cast(bf16x8, wq); } }
    float mhat = 0.f, l_reg = 0.f; f32x16 o[2], negm; { float z_ = 0.f; asm volatile("" : "+v"(z_));
#pragma unroll
      for (int r = 0; r < 16; ++r) { o[0][r] = z_; o[1][r] = z_; negm[r] = z_; } }
    asm volatile("" : "+v"(negm));
    ALAS float* wsf = (ALAS float*)(lds + B_WSF) + w * 64; ALAS bf16_t* stg = (ALAS bf16_t*)(lds + B_OST + w * 4096);
    const int qrel = 32 * w + r32; bool resc = false;
    f32x16 pA0, pA1, pB0, pB1; bf16x8 kf[8]; s16x4 vlo[8], vhi[8]; u32x4 pw0, pw1, pw2, pw3;
#define ROT() do { sl_prev = sl_cur; sl_cur = sl_next; sl_next = (sl_next == 2 * B_VSZ) ? 0 : sl_next + B_VSZ; } while (0)
#define CMASK(P0, P1, t) do { const int jb_ = (t) - (NT - 4); if (jb_ >= 0) { asm volatile("s_nop 15\n\ts_nop 7" : "+v"(P0), "+v"(P1)); bmask(P0, P1, jb_, qrel, hi); } } while (0)
#define RESC() do { if (resc) { asm volatile("s_waitcnt lgkmcnt(0)" ::: "memory"); \
      _Pragma("unroll") for (int g_ = 0; g_ < 4; ++g_) { const f32x4 v_ = *(const ALAS f32x4*)(wsf + 8 * g_ + 4 * hi); \
          _Pragma("unroll") for (int e_ = 0; e_ < 4; ++e_) { o[0][4 * g_ + e_] *= v_[e_]; o[1][4 * g_ + e_] *= v_[e_]; } } } } while (0)
    B_WAIT_BAR(0);
    DMA_K(3, 3 * B_KSZ); DMA_V(1, sl_next);
    { const ALAS char* kb = kp0;
#pragma unroll
      for (int d0 = 0; d0 < 6; ++d0) { const bf16x8 k0 = *(const ALAS bf16x8*)(kb + d0 * 2048), k1 = *(const ALAS bf16x8*)(kb + d0 * 2048 + 512);
          if (d0 == 0) { pA0 = B_MFMA(k0, qr[0], negm); pA1 = B_MFMA(k1, qr[0], negm); } else { pA0 = B_MFMA(k0, qr[d0], pA0); pA1 = B_MFMA(k1, qr[d0], pA1); } } }
    asm volatile("s_nop 15\n\ts_nop 7" : "+v"(pA0), "+v"(pA1));
    if (NT == 4) bmask(pA0, pA1, 0, qrel, hi);
    { float rm = -INFINITY;
#pragma unroll
      for (int r = 0; r < 16; ++r) rm = fmaxf(rm, fmaxf(pA0[r], pA1[r]));
      rm = xhalf_max(rm); mhat = rm;
#pragma unroll
      for (int r = 0; r < 16; ++r) { pA0[r] = __builtin_amdgcn_exp2f(pA0[r] - rm); pA1[r] = __builtin_amdgcn_exp2f(pA1[r] - rm); }
#pragma unroll
      for (int r = 0; r < 16; ++r) negm[r] = -mhat;
      asm volatile("" : "+v"(negm)); }
    B_SBAR(); PIN(pA0); PIN(pA1);
    ROT();
    kload2(kf, kp0 + KSL(1), 0, 0); kload2(kf, kp0 + KSL(1), 1, 1);
    if (two) { B_WAIT_BAR(3); } else { B_WAIT_BAR(2); }
#define PKW(P, B) pkbf(P[B], P[(B) + 1])
#define PAF(k) __builtin_bit_cast(bf16x8, pw##k)
#define VFR(i) (bf16x8){vlo[i][0], vlo[i][1], vlo[i][2], vlo[i][3], vhi[i][0], vhi[i][1], vhi[i][2], vhi[i][3]}
#define MX3(a, b, c) __builtin_fmaxf(__builtin_fmaxf((a), (b)), (c))
#define GAPA(MF, A0, A1, A2, A3, W0, W1, PW) do { MF; sacc += A0; sacc += A1; sacc += A2; sacc += A3; PIN(sacc); W0; W1; PIN(PW); B_SBAR(); } while (0)
#define EX(v) __builtin_amdgcn_exp2f(v)
#define GAPB(MF, X, B) do { MF; X[B] = EX(X[B]); X[(B) + 1] = EX(X[(B) + 1]); X[(B) + 2] = EX(X[(B) + 2]); X[(B) + 3] = EX(X[(B) + 3]); PIN(X); B_SBAR(); } while (0)
#define VRD(i) do { vlo[i] = vtr(vp_ + (((i) >> 2) * 4096 + ((i) & 3) * 1024)); vhi[i] = vtr(vp_ + (((i) >> 2) * 4096 + ((i) & 3) * 1024 + 512)); } while (0)
#define KRD(G, j) do { if (G) { kload2(kf, kp0 + KSL((t_) + 1), j, j); B_SBAR(); } } while (0)
#define STEP(C0, C1, P0, P1, t, GK, GV, GL) do { B_SBAR(); const int t_ = (t); \
    asm volatile("" : "=v"(pw0), "=v"(pw1), "=v"(pw2), "=v"(pw3));        \
    const ALAS char* vp_ = vp0 + sl_prev; const ALAS char* kr_ = kp0 + KSL(t_); \
    float sacc = (P0[0] + P0[1]); \
    kload2(kf, kr_, 2, 2); B_SBAR(); GAPA(C0 = B_MFMA(kf[0], qr[0], negm), P0[2], P0[3], P0[4], P0[5],     pw0[0] = PKW(P0, 0),  pw0[1] = PKW(P0, 2),  pw0); \
    kload2(kf, kr_, 3, 3); B_SBAR(); GAPA(C1 = B_MFMA(kf[1], qr[0], negm), P0[6], P0[7], P0[8], P0[9],     pw0[2] = PKW(P0, 4),  pw0[3] = PKW(P0, 6),  pw0); \
    VRD(0); B_SBAR(); GAPA(C0 = B_MFMA(kf[2], qr[1], C0),   P0[10], P0[11], P0[12], P0[13], pw1[0] = PKW(P0, 8),  pw1[1] = PKW(P0, 10), pw1); \
    VRD(4); B_SBAR(); GAPA(C1 = B_MFMA(kf[3], qr[1], C1),   P0[14], P0[15], P1[0], P1[1],   pw1[2] = PKW(P0, 12), pw1[3] = PKW(P0, 14), pw1); \
    kload2(kf, kr_, 4, 0); VRD(1); B_SBAR(); GAPA(C0 = B_MFMA(kf[4], qr[2], C0),   P1[2], P1[3], P1[4], P1[5],     pw2[0] = PKW(P1, 0),  pw2[1] = PKW(P1, 2),  pw2); \
    kload2(kf, kr_, 5, 1); VRD(5); B_SBAR(); GAPA(C1 = B_MFMA(kf[5], qr[2], C1),   P1[6], P1[7], P1[8], P1[9],     pw2[2] = PKW(P1, 4),  pw2[3] = PKW(P1, 6),  pw2); \
    VRD(2); B_SBAR(); GAPA(C0 = B_MFMA(kf[6], qr[3], C0),   P1[10], P1[11], P1[12], P1[13], pw3[0] = PKW(P1, 8),  pw3[1] = PKW(P1, 10), pw3); \
    VRD(6); B_SBAR(); GAPA(C1 = B_MFMA(kf[7], qr[3], C1),   P1[14], P1[15], 0.f, 0.f,       pw3[2] = PKW(P1, 12), pw3[3] = PKW(P1, 14), pw3); \
    l_reg += sacc; \
    VRD(3); B_SBAR(); C0 = B_MFMA(kf[0], qr[4], C0); B_SBAR(); VRD(7); B_SBAR(); C1 = B_MFMA(kf[1], qr[4], C1); B_SBAR(); C0 = B_MFMA(kf[2], qr[5], C0); B_SBAR(); C1 = B_MFMA(kf[3], qr[5], C1); B_SBAR(); \
    if (GK) { DMA_K(t_ + 3, KSL(t_ + 3)); } if (GV) { DMA_V(t_ + 1, sl_next); } NXTH(); \
    CMASK(C0, C1, t_); \
    { float a = MX3(C0[0], C0[1], C1[0]), b_ = MX3(C0[2], C0[3], C1[1]); a = MX3(a, C1[2], C1[3]); \
      _Pragma("unroll") for (int r = 4; r < 16; r += 4) { a = MX3(a, C0[r], C0[r + 1]); b_ = MX3(b_, C0[r + 2], C0[r + 3]); a = MX3(a, C1[r], C1[r + 1]); b_ = MX3(b_, C1[r + 2], C1[r + 3]); } \
      float rm = xhalf_max(__builtin_fmaxf(a, b_)); \
      resc = false; \
      if (__builtin_expect(__any(rm > 8.0f), 0)) { const float dl = __builtin_fmaxf(rm, 0.f); mhat += dl; \
        _Pragma("unroll") for (int r = 0; r < 16; ++r) { C0[r] -= dl; C1[r] -= dl; } \
        _Pragma("unroll") for (int r = 0; r < 16; ++r) negm[r] = -mhat; asm volatile("" : "+v"(negm)); \
        const float f = __builtin_amdgcn_exp2f(-dl); l_reg *= f; if (hi == 0) wsf[r32] = f; resc = true; } } \
    B_SBAR(); \
    GAPB(o[0] = B_MFMA(PAF(0), VFR(0), o[0]), C0, 0); \
    GAPB(o[1] = B_MFMA(PAF(0), VFR(4), o[1]), C0, 4); \
    KRD(GL, 0); GAPB(o[0] = B_MFMA(PAF(1), VFR(1), o[0]), C0, 8); \
    KRD(GL, 1); GAPB(o[1] = B_MFMA(PAF(1), VFR(5), o[1]), C0, 12); \
    GAPB(o[0] = B_MFMA(PAF(2), VFR(2), o[0]), C1, 0); \
    GAPB(o[1] = B_MFMA(PAF(2), VFR(6), o[1]), C1, 4); \
    GAPB(o[0] = B_MFMA(PAF(3), VFR(3), o[0]), C1, 8); \
    GAPB(o[1] = B_MFMA(PAF(3), VFR(7), o[1]), C1, 12); \
    } while (0)
#define STEADYW() do { if (two) { B_WAIT_BAR(3); } else { B_WAIT_BAR(2); } } while (0)
#define ENDW(tt) do { if ((tt) + 3 < NT) { STEADYW(); } else if ((tt) + 2 < NT) { B_WAIT_BAR(1); } else { B_WAIT_BAR(0); } } while (0)
#define NXTH() do { } while (0)
    int t = 1;
    do {
        STEP(pB0, pB1, pA0, pA1, t, (t + 3 < NT), (t + 1 < NT), (t + 1 < NT));         ENDW(t);     RESC(); ROT();
        STEP(pA0, pA1, pB0, pB1, t + 1, (t + 4 < NT), (t + 2 < NT), (t + 2 < NT));     ENDW(t + 1); RESC(); ROT();
        t += 2;
    } while (t + 1 < NT);
#undef NXTH
#define NXTH() do { if (nxt) { const bf16_t* ksn_ = ksrc + (nh - h) * 96; const bf16_t* vsn_ = vsrc + (nh - h) * 64; \
        _Pragma("unroll") for (int i_ = 0; i_ < 3; ++i_) { glds16(ksn_ + (size_t)i_ * 64 * 1536, (unsigned)__builtin_amdgcn_readfirstlane(kdst + i_ * B_KSZ)); \
            if (two) glds16(ksn_ + (size_t)i_ * 64 * 1536 + 64, (unsigned)__builtin_amdgcn_readfirstlane(kdst + i_ * B_KSZ + 8192)); } \
        glds16(vsn_, (unsigned)__builtin_amdgcn_readfirstlane(vdst + nvs * B_VSZ)); } } while (0)
    STEP(pB0, pB1, pA0, pA1, NT - 1, false, false, false); RESC();
    { float sacc = pB0[0] + pB0[1];
#pragma unroll
      for (int r = 2; r < 16; ++r) sacc += pB0[r];
#pragma unroll
      for (int r = 0; r < 16; ++r) sacc += pB1[r];
      l_reg += sacc;
      pw0 = (u32x4){PKW(pB0, 0), PKW(pB0, 2), PKW(pB0, 4), PKW(pB0, 6)}; pw1 = (u32x4){PKW(pB0, 8), PKW(pB0, 10), PKW(pB0, 12), PKW(pB0, 14)};
      pw2 = (u32x4){PKW(pB1, 0), PKW(pB1, 2), PKW(pB1, 4), PKW(pB1, 6)}; pw3 = (u32x4){PKW(pB1, 8), PKW(pB1, 10), PKW(pB1, 12), PKW(pB1, 14)};
      const ALAS char* vp_ = vp0 + sl_cur;
#pragma unroll
      for (int i = 0; i < 8; ++i) VRD(i);
      o[0] = B_MFMA(PAF(0), VFR(0), o[0]); o[1] = B_MFMA(PAF(0), VFR(4), o[1]); o[0] = B_MFMA(PAF(1), VFR(1), o[0]); o[1] = B_MFMA(PAF(1), VFR(5), o[1]);
      o[0] = B_MFMA(PAF(2), VFR(2), o[0]); o[1] = B_MFMA(PAF(2), VFR(6), o[1]); o[0] = B_MFMA(PAF(3), VFR(3), o[0]); o[1] = B_MFMA(PAF(3), VFR(7), o[1]); }
    l_reg = xhalf_sum(l_reg);
    if (nxt) {
#pragma unroll
        for (int d0 = 0; d0 < 6; ++d0) qraw[d0] = *(const bf16x8*)(T.QR + (size_t)((int)rowb + nqb * 256 + 32 * w + r32) * 1536 + nh * 96 + d0 * 16 + hi * 8); }
    store_o(o, 1.0f / l_reg, wsf, stg, T.O + (rowb + q0 + 32 * w) * 1024 + h * 64, 1024, lane);
#undef PKW
#undef PAF
#undef VFR
#undef PIN
#undef MX3
#undef GAPA
#undef GAPB
#undef EX
#undef VRD
#undef KRD
#undef STEP
#undef STEADYW
#undef ENDW
#undef NXTH
#undef CMASK
#undef RESC
#undef ROT
#undef DMA_K
#undef DMA_V
#undef KSL
}
}
namespace mk {
#define LAS __attribute__((address_space(3)))
typedef unsigned short bf16;
typedef unsigned v4u __attribute__((ext_vector_type(4)));
typedef float f32x4 __attribute__((ext_vector_type(4)));
constexpr int M = 16384, D = 1024, FF = 2816, S = 2048, NB = 8, NWAVES = 8;
constexpr size_t MiB = 1u << 20, KiB = 1u << 10;
constexpr size_t WS_CTL = 0, CTL_BYTES = 1 * MiB;
constexpr size_t WS_SSP = 1 * MiB;
constexpr size_t WS_SSQ = 2 * MiB, WS_SSKV = 2 * MiB + 256 * KiB, WS_SSR = 2 * MiB + 512 * KiB, WS_KR = 3 * MiB, WS_CST = 5 * MiB;
constexpr size_t SZ_GU = (size_t)2 * FF * D * 2, SZ_DN = (size_t)D * FF * 2, SZ_AIN = (size_t)1280 * D * 2, SZ_SQ = (size_t)D * D * 2, SZ_BIN = (size_t)512 * D * 2, SZ_UQ = (size_t)1536 * 256 * 2, SZ_UKV = (size_t)2048 * 256 * 2;
constexpr size_t W_GU1_0 = 8 * MiB, W_D1_0 = W_GU1_0 + SZ_GU, W_AIN = W_D1_0 + SZ_DN, W_AOUT = W_AIN + SZ_AIN, W_GU2_0 = W_AOUT + SZ_SQ, W_D2_0 = W_GU2_0 + SZ_GU, W_GU1_1 = W_D2_0 + SZ_DN, W_D1_1 = W_GU1_1 + SZ_GU,
                 W_BIN = W_D1_1 + SZ_DN, W_UQ = W_BIN + SZ_BIN, W_UKV = W_UQ + SZ_UQ, W_BOUT = W_UKV + SZ_UKV, W_GU2_1 = W_BOUT + SZ_SQ, W_D2_1 = W_GU2_1 + SZ_GU, W_END = W_D2_1 + SZ_DN;
constexpr size_t WS_XB = 84 * MiB;
constexpr size_t WS_BIG = 116 * MiB;
constexpr size_t WS_H = WS_BIG;
constexpr size_t WS_QA = 204 * MiB, WS_OA = WS_QA, WS_KA = 236 * MiB, WS_VA = 240 * MiB;
constexpr size_t WS_QR = WS_BIG, WS_KF = WS_BIG + 48 * MiB, WS_VF = WS_BIG + 96 * MiB;
constexpr size_t WS_OB = 8 * MiB, WS_CQ = 40 * MiB, WS_CKV = 48 * MiB;
constexpr size_t WS_END = 256 * MiB;
static_assert(WS_CST + (size_t)M * 32 * 4 <= W_GU1_0 && W_END <= WS_XB && WS_XB + (size_t)M * D * 2 <= WS_BIG && WS_H + (size_t)M * FF * 2 <= WS_END && WS_VF + (size_t)M * 1024 * 2 <= WS_END && WS_CKV + (size_t)M * 256 * 2 <= W_BIN && WS_VA + (size_t)M * 128 * 2 <= WS_END && WS_H + (size_t)M * FF * 2 <= WS_QA, "d_ws map");
constexpr int LDS_BYTES = 147456;
static_assert(att::A_END <= 131072 && att::B_END <= 131072, "attention LDS");

#define XB_TMO      128
#define XB_XCNT(j)  (256  + 64 * (j))
#define XB_XSUB(j)  (1280 + 64 * (j))
#define XB_XGEN(j)  (2304 + 64 * (j))
#define XB_TOP      3328
#define XB_TOPGEN   3392
#define XCD_BAR_WORDS 3456
#define XB_SPIN_CAP (1u << 18)

__device__ __forceinline__ unsigned xb_ld(unsigned* p)              { return __hip_atomic_load(p, __ATOMIC_RELAXED, __HIP_MEMORY_SCOPE_AGENT); }
__device__ __forceinline__ unsigned xb_add(unsigned* p, unsigned v) { return __hip_atomic_fetch_add(p, v, __ATOMIC_RELAXED, __HIP_MEMORY_SCOPE_AGENT); }
__device__ __forceinline__ unsigned xb_xcc_id() { return (unsigned)__builtin_amdgcn_s_getreg((3 << 11) | 20) & 0xFu; }
#define XB_SPIN(cond, bar) do { unsigned _sp = 0; while (cond) { __builtin_amdgcn_s_sleep(1); \
    if ((++_sp & 255u) == 0u) { if (xb_ld(&(bar)[XB_TMO])) break; if (_sp > XB_SPIN_CAP) { atomicAdd(&(bar)[XB_TMO], 1u); break; } } } } while (0)

struct XcdBarrier {
    unsigned* bar; unsigned x;
    volatile LAS unsigned* st;
};

__device__ __forceinline__ XcdBarrier xcd_barrier_post(unsigned* bar, volatile LAS unsigned* st, const bool lead) {
    XcdBarrier b; b.bar = bar; b.x = xb_xcc_id(); b.st = st;
    if (lead) (void)xb_add(&bar[XB_XCNT(b.x)], 1u);
    return b;
}
__device__ __forceinline__ void xcd_barrier_complete(unsigned* bar, unsigned x, unsigned& nloc, unsigned& nx) {
    const unsigned G = gridDim.x * gridDim.y * gridDim.z;
    unsigned sum, cnt, mine, sp = 0u;
    for (;;) {
        sum = 0u; cnt = 0u; mine = 0u;
#pragma unroll
        for (unsigned j = 0; j < 16; ++j) { const unsigned c = xb_ld(&bar[XB_XCNT(j)]); sum += c; cnt += (c > 0u) ? 1u : 0u; mine = (j == x) ? c : mine; }
        if (sum == G) break;
        __builtin_amdgcn_s_sleep(1);
        if ((++sp & 255u) == 0u) { if (xb_ld(&bar[XB_TMO])) break; if (sp > XB_SPIN_CAP) { atomicAdd(&bar[XB_TMO], 1u); break; } }
    }
    nloc = mine > 0u ? mine : 1u; nx = cnt > 0u ? cnt : 1u;
}

__device__ __forceinline__ void xcd_barrier(const XcdBarrier& b, const bool lead) {
    asm volatile("s_waitcnt vmcnt(0)" ::: "memory");
    __syncthreads();
    if (lead) {
        unsigned* bar = b.bar;
        __builtin_amdgcn_s_waitcnt(0);
        unsigned nloc = b.st[0], nx = b.st[1];
        if (nloc == 0u) { xcd_barrier_complete(bar, b.x, nloc, nx); b.st[0] = nloc; b.st[1] = nx; }
        const unsigned old = xb_add(&bar[XB_XSUB(b.x)], 1u);
        const unsigned gen = old / nloc;
        if (old + 1u == (gen + 1u) * nloc) {
            __builtin_amdgcn_fence(__ATOMIC_RELEASE, "agent");
            asm volatile("s_waitcnt vmcnt(0)" ::: "memory");
            const unsigned og = xb_add(&bar[XB_TOP], 1u);
            const unsigned tg = og / nx;
            if (og + 1u == (tg + 1u) * nx) xb_add(&bar[XB_TOPGEN], 1u);
            else XB_SPIN(xb_ld(&bar[XB_TOPGEN]) == tg, bar);
            __builtin_amdgcn_fence(__ATOMIC_ACQUIRE, "agent");
            xb_add(&bar[XB_XGEN(b.x)], 1u);
            asm volatile("s_waitcnt vmcnt(0)" ::: "memory");
        } else {
            XB_SPIN(xb_ld(&bar[XB_XGEN(b.x)]) == gen, bar);
            __builtin_amdgcn_fence(__ATOMIC_ACQUIRE, "agent");
            asm volatile("s_waitcnt vmcnt(0)" ::: "memory");
        }
    }
    __syncthreads();
}

#define CW_GRP 8192
#define CW_XID 9216
#define CW_TEAM 10240
__device__ __forceinline__ void group_barrier(unsigned* bar, unsigned* cnt, unsigned nmem, volatile LAS unsigned* fastw, const bool lead) {
    asm volatile("s_waitcnt vmcnt(0)" ::: "memory");
    __syncthreads();
    if (lead) {
        if (fastw[0] == 0u) { __builtin_amdgcn_fence(__ATOMIC_RELEASE, "agent"); asm volatile("s_waitcnt vmcnt(0)" ::: "memory"); }
        const unsigned old = xb_add(cnt, 1u);
        const unsigned target = (old / nmem + 1u) * nmem;
        XB_SPIN(xb_ld(cnt) < target, bar);
        __builtin_amdgcn_fence(__ATOMIC_ACQUIRE, "agent");
        asm volatile("s_waitcnt vmcnt(0)" ::: "memory");
    }
    __syncthreads();
}

constexpr int CW_BAR = 4096;
constexpr int MISC_OFF = 131072 + 320;
constexpr int AUX_OFF = 131072 + 1024;
struct Args { const void* in[25]; float* out; unsigned char* ws; };
__device__ __forceinline__ int opq(int v) { asm volatile("" : "+s"(v)); return v; }
__device__ __forceinline__ unsigned char* opqp(unsigned char* p) { asm volatile("" : "+s"(p)); return p; }
static_assert((CW_BAR + XCD_BAR_WORDS) <= CW_GRP && (CW_XID + 1024) <= CW_TEAM && (CW_TEAM + 64 * 64) * 4 <= 64 * 1024, "barrier words inside the memset");


__device__ __forceinline__ float wave_sum(float v) {
#pragma unroll
    for (int o = 1; o < 64; o <<= 1) v += __shfl_xor(v, o);
    return v;
}
__device__ __forceinline__ unsigned f2bf(float f) { unsigned u = __builtin_bit_cast(unsigned, f); return (u + 0x7fffu + ((u >> 16) & 1u)) >> 16; }
__device__ __forceinline__ unsigned pk2(float lo, float hi) { return f2bf(lo) | (f2bf(hi) << 16); }

enum { K_NAT = 0, K_GU0 = 1, K_GU1 = 2, K_AIN = 3, K_BIN = 4, K_UKV = 5 };
struct Job { const float* w; const float* gain; bf16* dst; int kind, Kd, Ks, Ns; };
typedef unsigned u32x4 __attribute__((ext_vector_type(4)));
__device__ __forceinline__ void conv_item(const Job& J, int item, int lane) {
    const int nblk = (J.Ns + 63) >> 6, kb = item / nblk, nb = item - kb * nblk;
    const int g = lane >> 4, c = lane & 15, k0 = 64 * kb + 16 * g, col0 = 64 * nb + 4 * c;
    if (col0 >= J.Ns) return;
    const float* src = J.w + (size_t)k0 * J.Ns + col0;
    f32x4 v[16];
#pragma unroll
    for (int i = 0; i < 16; ++i) v[i] = __builtin_nontemporal_load((const f32x4*)(src + (size_t)i * J.Ns));
    if (J.gain) {
#pragma unroll
        for (int q = 0; q < 4; ++q) { const f32x4 gn = *(const f32x4*)(J.gain + k0 + 4 * q);
#pragma unroll
            for (int j = 0; j < 4; ++j) v[4 * q + j] = v[4 * q + j] * gn[j]; } }
    int r0 = col0;
    if (J.kind == K_GU0 || J.kind == K_GU1) r0 = 256 * (col0 >> 7) + (col0 & 127) + (J.kind == K_GU1 ? 128 : 0);
    else if (J.kind == K_AIN) { const int pn = col0 >> 8, wc = (col0 >> 6) & 3, bj = (col0 >> 5) & 1, i = col0 & 31; r0 = 256 * pn + 128 * bj + 32 * wc + i; }
    else if (J.kind == K_BIN) { if (col0 >= 384) { const int dd = col0 - 384; r0 = 384 + 8 * ((dd >> 2) & 3) + 4 * (dd >> 4) + (dd & 3); } }
    else if (J.kind == K_UKV) { const int head = col0 >> 7, t = col0 & 127, isv = t >> 6, tt = t & 63; r0 = 256 * ((head >> 2) + 4 * isv) + 128 * (tt >> 5) + 32 * (head & 3) + (tt & 31); }
#pragma unroll
    for (int e = 0; e < 4; ++e) { bf16* dp = J.dst + (size_t)(r0 + e) * J.Kd + k0;
        u32x4 w0, w1; w0.x = pk2(v[0][e], v[1][e]); w0.y = pk2(v[2][e], v[3][e]); w0.z = pk2(v[4][e], v[5][e]); w0.w = pk2(v[6][e], v[7][e]);
        w1.x = pk2(v[8][e], v[9][e]); w1.y = pk2(v[10][e], v[11][e]); w1.z = pk2(v[12][e], v[13][e]); w1.w = pk2(v[14][e], v[15][e]);
        *(u32x4*)dp = w0; *(u32x4*)(dp + 8) = w1; }
}
constexpr int NJOBS = 18;
__device__ __forceinline__ Job get_job(const Args& a, int j) {
    unsigned char* ws = a.ws; Job J;
    const float* ffn_norm1 = (const float*)a.in[3]; const float* ffn1_wg = (const float*)a.in[4]; const float* ffn1_wu = (const float*)a.in[5]; const float* ffn1_wd = (const float*)a.in[6];
    const float* mix_norm = (const float*)a.in[7]; const float* ffn_norm2 = (const float*)a.in[8]; const float* ffn2_wg = (const float*)a.in[9]; const float* ffn2_wu = (const float*)a.in[10]; const float* ffn2_wd = (const float*)a.in[11];
    const size_t GU = (size_t)D * FF;
    switch (j) {
        case 0:  J = Job{ffn1_wg, ffn_norm1, (bf16*)(ws + W_GU1_0), K_GU0, D, D, FF}; break;
        case 1:  J = Job{ffn1_wu, ffn_norm1, (bf16*)(ws + W_GU1_0), K_GU1, D, D, FF}; break;
        case 2:  J = Job{ffn1_wd, nullptr, (bf16*)(ws + W_D1_0), K_NAT, FF, FF, D}; break;
        case 3:  J = Job{(const float*)a.in[12], mix_norm, (bf16*)(ws + W_AIN), K_AIN, D, D, 1280}; break;
        case 4:  J = Job{(const float*)a.in[16], nullptr, (bf16*)(ws + W_AOUT), K_NAT, D, D, D}; break;
        case 5:  J = Job{ffn2_wg, ffn_norm2, (bf16*)(ws + W_GU2_0), K_GU0, D, D, FF}; break;
        case 6:  J = Job{ffn2_wu, ffn_norm2, (bf16*)(ws + W_GU2_0), K_GU1, D, D, FF}; break;
        case 7:  J = Job{ffn2_wd, nullptr, (bf16*)(ws + W_D2_0), K_NAT, FF, FF, D}; break;
        case 8:  J = Job{ffn1_wg + GU, ffn_norm1 + D, (bf16*)(ws + W_GU1_1), K_GU0, D, D, FF}; break;
        case 9:  J = Job{ffn1_wu + GU, ffn_norm1 + D, (bf16*)(ws + W_GU1_1), K_GU1, D, D, FF}; break;
        case 10: J = Job{ffn1_wd + GU, nullptr, (bf16*)(ws + W_D1_1), K_NAT, FF, FF, D}; break;
        case 11: J = Job{(const float*)a.in[17], mix_norm + D, (bf16*)(ws + W_BIN), K_BIN, D, D, 416}; break;
        case 12: J = Job{(const float*)a.in[20], (const float*)a.in[18], (bf16*)(ws + W_UQ), K_NAT, 256, 256, 1536}; break;
        case 13: J = Job{(const float*)a.in[21], (const float*)a.in[19], (bf16*)(ws + W_UKV), K_UKV, 128, 128, 2048}; break;
        case 14: J = Job{(const float*)a.in[24], nullptr, (bf16*)(ws + W_BOUT), K_NAT, D, D, D}; break;
        case 15: J = Job{ffn2_wg + GU, ffn_norm2 + D, (bf16*)(ws + W_GU2_1), K_GU0, D, D, FF}; break;
        case 16: J = Job{ffn2_wu + GU, ffn_norm2 + D, (bf16*)(ws + W_GU2_1), K_GU1, D, D, FF}; break;
        default: J = Job{ffn2_wd + GU, nullptr, (bf16*)(ws + W_D2_1), K_NAT, FF, FF, D}; break;
    }
    return J;
}
__device__ __forceinline__ void convert_jobs(const Args& a, int jlo, int jhi, int wk, int nwg, int wv, int) {
    int tid = tid_of(wv);
    const int lane = tid & 63, wave = wv;
    const int gw = wk * NWAVES + wave, NGW = nwg * NWAVES;
    int base = 0;
    for (int j = jlo; j < jhi; ++j) {
        const Job J = get_job(a, j); const int nitems = (J.Ks >> 6) * ((J.Ns + 63) >> 6);
        const int first = (gw - base % NGW + NGW) % NGW;
        for (int it = first; it < nitems; it += NGW) conv_item(J, it, lane);
        base += nitems;
    }
}
__device__ __forceinline__ void zero_pads(const Args& a, int wk, int nwg, int wv, int) {
    int tid = tid_of(wv);
    const int lane = tid & 63, wave = wv;
    const int gw = wk * NWAVES + wave, NGW = nwg * NWAVES;
    unsigned zz = 0u; asm volatile("" : "+v"(zz)); const u32x4 z = (u32x4){zz, zz, zz, zz}; u32x4* bin = (u32x4*)(a.ws + W_BIN + (size_t)416 * D * 2);
    for (int e = gw * 64 + lane; e < 96 * 128; e += NGW * 64) bin[e] = z;
}
__device__ __forceinline__ void prologue(const Args& a, int vcu, int G, int wave, int lane) {
    const int gw = vcu * NWAVES + wave, NGW = G * NWAVES;
    convert_jobs(a, 0, 4, vcu, G, wave, lane);
    const float* x = (const float*)a.in[0]; bf16* xb = (bf16*)(a.ws + WS_XB); float* ssp = (float*)(a.ws + WS_SSP);
    for (int m = gw; m < M; m += NGW) {
        const f32x4* xr = (const f32x4*)(x + (size_t)m * D) + lane; f32x4 v[4]; float s = 0.f;
#pragma unroll
        for (int j = 0; j < 4; ++j) { v[j] = xr[64 * j]; s += (v[j][0] * v[j][0] + v[j][1] * v[j][1]) + (v[j][2] * v[j][2] + v[j][3] * v[j][3]); }
        s = wave_sum(s);
        unsigned long long* o8 = (unsigned long long*)(xb + (size_t)m * D) + lane;
#pragma unroll
        for (int j = 0; j < 4; ++j) o8[64 * j] = (unsigned long long)pk2(v[j][0], v[j][1]) | ((unsigned long long)pk2(v[j][2], v[j][3]) << 32);
        if (lane < 16) ssp[(size_t)m * 16 + lane] = lane == 0 ? s : 0.f;
    }
    { const int* pos = (const int*)a.in[1]; float* cst = (float*)(a.ws + WS_CST);
      for (int e = gw * 64 + lane; e < M * 16; e += NGW * 64) { const int m = e >> 4, i = e & 15; float cs, sn; pg8::rope_cs((float)pos[m], i, cs, sn); cst[(size_t)m * 32 + i] = cs; cst[(size_t)m * 32 + 16 + i] = sn; } }
}
#ifndef PROBE
#define PROBE 0
#endif
__global__ void __launch_bounds__(NWAVES * 64, 2) mega(Args a) {
    extern __shared__ __attribute__((aligned(16))) unsigned char lds_raw[];
    LAS unsigned char* lds = (LAS unsigned char*)lds_raw;
    const int wave = __builtin_amdgcn_readfirstlane((int)threadIdx.x >> 6);
#define tid tid_of(wave)
#define lane (tid_of(wave) & 63)
    const int G = gridDim.x, bx = blockIdx.x; const int vcu = (G % 8 == 0) ? (bx % 8) * (G / 8) + bx / 8 : bx;
    unsigned char* ws = a.ws;
    float* X = a.out; bf16* XB = (bf16*)(ws + WS_XB); float* SSP = (float*)(ws + WS_SSP);
    volatile LAS unsigned* MISC = (volatile LAS unsigned*)(lds + MISC_OFF);
    if (tid < 32) MISC[tid] = 0u;
    __syncthreads();
    const XcdBarrier bar = xcd_barrier_post((unsigned*)(ws + WS_CTL) + CW_BAR, MISC + 8, tid == 0);
    const bool use_grp = (G % 8 == 0) && G <= 1024;
    if (tid == 0) __hip_atomic_store((unsigned*)(ws + WS_CTL) + CW_XID + bx, 1u + xb_xcc_id(), __ATOMIC_RELAXED, __HIP_MEMORY_SCOPE_AGENT);
#define GRID_SYNC() do { XcdBarrier b_ = bar; asm volatile("" : "+s"(b_.bar), "+s"(b_.x)); xcd_barrier(b_, tid == 0); } while (0)
#define XBp() ((bf16*)(opqp(a.ws) + WS_XB))
#define SSPp() ((float*)(opqp(a.ws) + WS_SSP))
#define Xp() ((float*)opqp((unsigned char*)a.out))
    for (int rep = 0; rep < (PROBE == 1 ? 2 : 1); ++rep) prologue(a, vcu, G, wave, lane);
    GRID_SYNC();
    if (PROBE == 2) for (int rep = 0; rep < 10; ++rep) GRID_SYNC();
    if (tid == 0) {
        unsigned same = use_grp ? 1u : 0u; const unsigned mine = 1u + xb_xcc_id();
        for (int j = bx & 7; j < G && use_grp; j += 8) same &= (__hip_atomic_load((unsigned*)(ws + WS_CTL) + CW_XID + j, __ATOMIC_RELAXED, __HIP_MEMORY_SCOPE_AGENT) == mine) ? 1u : 0u;
        MISC[10] = same; }
    __syncthreads();
#define GROUP_SYNC() do { if (use_grp) { unsigned* cw_ = (unsigned*)(ws + WS_CTL); asm volatile("" : "+s"(cw_)); group_barrier(cw_ + CW_BAR, cw_ + CW_GRP + 64 * (bx & 7), (unsigned)opq(G >> 3), MISC + 10, tid == 0); } else GRID_SYNC(); } while (0)
    const bool use_team = use_grp && (G % 64 == 0);
#define TEAM_SYNC() do { if (use_team) { unsigned* cw_ = (unsigned*)(ws + WS_CTL); asm volatile("" : "+s"(cw_)); group_barrier(cw_ + CW_BAR, cw_ + CW_TEAM + 64 * opq(((bx & 7) << 3) | ((bx >> 3) & 7)), (unsigned)opq(G >> 6), MISC + 10, tid == 0); } else GROUP_SYNC(); } while (0)
    for (int L = 0; L < 2; ++L) {
        for (int half = 0; half < 2; ++half) {
            { const size_t woff = (L == 0) ? (half == 0 ? W_GU1_0 : W_GU2_0) : (half == 0 ? W_GU1_1 : W_GU2_1);
              const bool tailconv = (L == 1 && half == 0);
              pg8::Gemm g{XBp(), (const bf16*)(opqp(a.ws) + woff), M, 2 * FF, D}; pg8::HalfTailOrder So; So.init(M, 2 * FF, opq(G), opq(bx)); So.use_half = false;
              LAS float* rsl = (LAS float*)(lds + AUX_OFF);
              pg8::EpiSwiGLU E{(bf16*)(opqp(a.ws) + WS_H), FF, rsl, SSPp()};
              for (int rep = 0; rep < (PROBE == 5 ? 2 : 1); ++rep) pg8::gemm_phase<pg8::EpiSwiGLU, pg8::HalfTailOrder, true, true>(lds, g, So, E, wave);
              if (tailconv) { const int nidle = G - (64 * 22) % G;
                  if (nidle > 0 && nidle < G) { if (bx >= G - nidle) { convert_jobs(a, 11, 18, bx - (G - nidle), nidle, wave, lane); zero_pads(a, bx - (G - nidle), nidle, wave, lane); } }
                  else { convert_jobs(a, 11, 18, bx, G, wave, lane); zero_pads(a, bx, G, wave, lane); } } }
            TEAM_SYNC();
            { const size_t woff = (L == 0) ? (half == 0 ? W_D1_0 : W_D2_0) : (half == 0 ? W_D1_1 : W_D2_1);
              pg8::Gemm g{(const bf16*)(opqp(a.ws) + WS_H), (const bf16*)(opqp(a.ws) + woff), M, D, FF}; pg8::StaticOrder So; So.init(M, D, opq(G), opq(bx));
              pg8::EpiResid E{(const float*)Xp(), Xp(), XBp(), SSPp(), 0.5f, L == 1 && half == 1};
              for (int rep = 0; rep < (PROBE == 6 ? 2 : 1); ++rep) { pg8::gemm_phase<pg8::EpiResid, pg8::StaticOrder, true, true>(lds, g, So, E, wave); E.R = Xp(); E.alpha = 0.f; } }
            if (L == 1 && half == 1) break;
            if (L == 1 && half == 0) GRID_SYNC(); else TEAM_SYNC();
            if (half == 1) continue;
            const bf16* Oat; const bf16* Wout;
            if (L == 0) {
                { pg8::Gemm g{XBp(), (const bf16*)(opqp(a.ws) + W_AIN), M, 1280, D}; pg8::StaticOrder So; So.init(M, 1280, opq(G), opq(bx));
                  pg8::EpiQKV E{(bf16*)(opqp(a.ws) + WS_QA), (bf16*)(opqp(a.ws) + WS_KA), (bf16*)(opqp(a.ws) + WS_VA), SSPp(), (const float*)a.in[13], (const float*)a.in[14], 0.125f * 1.4426950408889634f, (LAS float*)(lds + AUX_OFF)};
                  for (int rep = 0; rep < (PROBE == 8 ? 2 : 1); ++rep) pg8::gemm_phase<pg8::EpiQKV, pg8::StaticOrder, true, true>(lds, g, So, E, wave);
                  const int nidle = G - (64 * 5) % G;
                  if (nidle > 0 && nidle < G) { if (bx >= G - nidle) convert_jobs(a, 4, 11, bx - (G - nidle), nidle, wave, lane); }
                  else convert_jobs(a, 4, 11, bx, G, wave, lane); }
                GROUP_SYNC();
                { att::AttnA T{(const bf16*)(opqp(a.ws) + WS_QA), (const bf16*)(opqp(a.ws) + WS_KA), (const bf16*)(opqp(a.ws) + WS_VA), (bf16*)(opqp(a.ws) + WS_OA), (const int*)a.in[1], (const float*)a.in[2], (const float*)a.in[15]};
                  for (int rep = 0; rep < (PROBE == 3 ? 2 : 1); ++rep) if (use_grp) { for (int j = bx >> 3; j < 32; j += G >> 3) att::attnA_unit((LAS char*)lds, T, bx & 7, j >> 1, j & 1, wave); }
                  else for (int u = bx; u < NB * 16 * 2; u += G) att::attnA_unit((LAS char*)lds, T, u >> 5, (u >> 1) & 15, u & 1, wave);
                  __syncthreads(); }
                Oat = (const bf16*)(opqp(a.ws) + WS_OA); Wout = (const bf16*)(opqp(a.ws) + W_AOUT);
            } else {
                { pg8::Gemm g{XBp(), (const bf16*)(opqp(a.ws) + W_BIN), M, 512, D}; pg8::HalfTailOrder So; So.init(M, 512, opq(G), opq(bx)); So.use_half = true;
                  pg8::EpiBIn E{(bf16*)(opqp(a.ws) + WS_CQ), (bf16*)(opqp(a.ws) + WS_CKV), (float*)(opqp(a.ws) + WS_SSQ), (float*)(opqp(a.ws) + WS_SSKV), (float*)(opqp(a.ws) + WS_SSR), (float*)(opqp(a.ws) + WS_KR), SSPp(), (const float*)(opqp(a.ws) + WS_CST), (const float*)a.in[23], (LAS float*)(lds + AUX_OFF)};
                  for (int rep = 0; rep < (PROBE == 9 ? 2 : 1); ++rep) pg8::gemm_phase<pg8::EpiBIn, pg8::HalfTailOrder, true, true, true>(lds, g, So, E, wave); }
                GROUP_SYNC();
                { pg8::Gemm g{(const bf16*)(opqp(a.ws) + WS_CQ), (const bf16*)(opqp(a.ws) + W_UQ), M, 1536, 256}; pg8::HalfTailOrder So; So.init(M, 1536, opq(G), opq(bx)); So.use_half = true;
                  pg8::EpiUQ E{(bf16*)(opqp(a.ws) + WS_QR), (const float*)(opqp(a.ws) + WS_SSQ), (LAS float*)(lds + AUX_OFF)};
                  for (int rep = 0; rep < (PROBE == 9 ? 2 : 1); ++rep) pg8::gemm_phase<pg8::EpiUQ, pg8::HalfTailOrder, true, true, true>(lds, g, So, E, wave); }
                { pg8::Gemm g{(const bf16*)(opqp(a.ws) + WS_CKV), (const bf16*)(opqp(a.ws) + W_UKV), M, 2048, 128}; pg8::StaticOrder So; So.init(M, 2048, opq(G), opq(bx));
                  pg8::EpiUKV E{(bf16*)(opqp(a.ws) + WS_KF), (bf16*)(opqp(a.ws) + WS_VF), (const float*)(opqp(a.ws) + WS_SSKV), (const float*)(opqp(a.ws) + WS_SSR), (const float*)(opqp(a.ws) + WS_KR), (LAS float*)(lds + AUX_OFF)};
                  for (int rep = 0; rep < (PROBE == 9 ? 2 : 1); ++rep) pg8::gemm_phase<pg8::EpiUKV, pg8::StaticOrder, true, true>(lds, g, So, E, wave); }
                GROUP_SYNC();
                { att::AttnB T{(const bf16*)(opqp(a.ws) + WS_QR), (const bf16*)(opqp(a.ws) + WS_KF), (const bf16*)(opqp(a.ws) + WS_VF), (bf16*)(opqp(a.ws) + WS_OB), (const float*)(opqp(a.ws) + WS_CST), (const float*)a.in[22], (const float*)a.in[23]};
                  att::attnB_prime((LAS char*)lds, T, wave);
                  for (int rep = 0; rep < (PROBE == 4 ? 2 : 1); ++rep) { int vs = 0; att::bf16x8 qraw[6]; bool pre = false; asm volatile("" : "=v"(qraw[0]), "=v"(qraw[1]), "=v"(qraw[2]), "=v"(qraw[3]), "=v"(qraw[4]), "=v"(qraw[5]));
                      if (use_grp) { const int jst = G >> 3; for (int j = bx >> 3; j < 64; j += jst) { const int hh = j >> 2, s = j & 3; const bool more = j + jst < 64;
                          att::attnB_unit((LAS char*)lds, T, bx & 7, hh, s, wave, pre, true, hh, 7 - s, vs, qraw);
                          att::attnB_unit((LAS char*)lds, T, bx & 7, hh, 7 - s, wave, true, more, (j + jst) >> 2, (j + jst) & 3, vs, qraw); pre = true; } }
                      else for (int p = bx; p < NB * 16 * 4; p += G) { const int bh = p >> 2, s = p & 3;
                          att::attnB_unit((LAS char*)lds, T, bh >> 4, bh & 15, s, wave, false, true, bh & 15, 7 - s, vs, qraw); att::attnB_unit((LAS char*)lds, T, bh >> 4, bh & 15, 7 - s, wave, true, false, 0, 0, vs, qraw); } }
                  asm volatile("s_waitcnt vmcnt(0) lgkmcnt(0)" ::: "memory"); __syncthreads(); }
                Oat = (const bf16*)(opqp(a.ws) + WS_OB); Wout = (const bf16*)(opqp(a.ws) + W_BOUT);
            }
            if (L == 0) GRID_SYNC(); else GROUP_SYNC();
            { pg8::Gemm g{Oat, Wout, M, D, D}; pg8::StaticOrder So; So.init(M, D, opq(G), opq(bx));
              pg8::EpiResid E{(const float*)Xp(), Xp(), XBp(), SSPp(), 1.0f, false};
              for (int rep = 0; rep < (PROBE == 7 ? 2 : 1); ++rep) { pg8::gemm_phase<pg8::EpiResid, pg8::StaticOrder, true, true>(lds, g, So, E, wave); E.alpha = 0.f; } }
            if (L == 1) GRID_SYNC(); else TEAM_SYNC();
        }
    }
}
#undef tid
#undef lane
}

extern "C" void kernel_launch(void* const* d_in, const int* in_sizes, int n_in, void* d_out, int out_size, void* d_ws, size_t ws_size, hipStream_t stream) {
    using namespace mk;
    static int grid = 0;
    if (grid == 0) {
        if (n_in != 25 || out_size != M * D || ws_size < WS_END) { fprintf(stderr, "kernel_launch: unexpected shapes (n_in %d out %d ws %zu)\n", n_in, out_size, ws_size); grid = -1; return; }
        int dev = 0, cus = 0, per_cu = 0;
        hipGetDevice(&dev); hipDeviceGetAttribute(&cus, hipDeviceAttributeMultiprocessorCount, dev);
        hipFuncSetAttribute((const void*)mega, hipFuncAttributeMaxDynamicSharedMemorySize, LDS_BYTES);
        hipOccupancyMaxActiveBlocksPerMultiprocessor(&per_cu, (const void*)mega, NWAVES * 64, LDS_BYTES);
        if (per_cu < 1) { fprintf(stderr, "kernel_launch: occupancy query says %d blocks per CU\n", per_cu); per_cu = 1; }
        (void)hipGetLastError();
        grid = cus;
    }
    if (grid < 0) return;
    Args a{};
    for (int i = 0; i < 25; ++i) a.in[i] = d_in[i];
    a.out = (float*)d_out; a.ws = (unsigned char*)d_ws;
    if (hipMemsetAsync((char*)d_ws + WS_CTL, 0, 64 * 1024, stream) != hipSuccess) { fprintf(stderr, "kernel_launch: memset failed\n"); return; }
    hipLaunchKernelGGL(mega, dim3(grid), dim3(NWAVES * 64), LDS_BYTES, stream, a);
    const hipError_t e = hipPeekAtLastError();
    if (e != hipSuccess) fprintf(stderr, "launch failed: %s (grid %d)\n", hipGetErrorName(e), grid);
}
```

```cpp
#include <hip/hip_runtime.h>
#include <cstdio>
#include <cstdint>
__device__ __forceinline__ int tid_of(int wv) { int t; asm volatile("v_mbcnt_lo_u32_b32 %0, -1, 0\n\tv_mbcnt_hi_u32_b32 %0, -1, %0" : "=v"(t)); return t + wv * 64; }
namespace pg8 {
#define PG8_LAS __attribute__((address_space(3)))
typedef unsigned short bf16_t;
typedef short bf16x8 __attribute__((ext_vector_type(8)));
typedef float f32x4 __attribute__((ext_vector_type(4)));
typedef unsigned u32x4 __attribute__((ext_vector_type(4)));
constexpr int BM = 256, BK = 64, HALF = 128, HTB = HALF * BK * 2  , STAGE_BYTES = 8 * HTB, NXCD = 8, WGM = 8;

__host__ __device__ __forceinline__ int lds_byte(int r, int c) { const int st = (r >> 4) * 2 + (c >> 5), rr = r & 15, cc = c & 31, ob = rr * 64 + cc * 2; return st * 1024 + (ob ^ (((ob >> 9) & 1) << 5)); }
__host__ __device__ __forceinline__ void stage_rc(int b, int& R, int& C) { const int st = b / 1024, sb = b % 1024, swz = sb ^ (((sb >> 9) & 1) << 5); R = (st >> 1) * 16 + swz / 64; C = (st & 1) * 32 + (swz % 64) / 2; }
__host__ __device__ __forceinline__ int perm32(int rho) { const int n = rho >> 4, i = rho & 15; return 8 * (i >> 2) + 4 * n + (i & 3); }

struct Unit { int pm, pn, half; };
struct Gemm { const bf16_t* A; const bf16_t* Bt; int M, N, K; };

struct StaticOrder {
    int nM, nN, nwg, G, c;
    __host__ __device__ __forceinline__ void init(int M, int N, int G_, int c_) { nM = M / BM; nN = N / BM; nwg = nM * nN; G = G_; c = c_; }
    __host__ __device__ __forceinline__ bool next(int i, Unit& u) const {
        const long L = (long)i * G + c; if (L >= nwg) return false;
        int wgid = (int)L; { const int q = nwg / NXCD, r = nwg % NXCD, xcd = wgid % NXCD, off = wgid / NXCD; wgid = (xcd < r ? xcd * (q + 1) : r * (q + 1) + (xcd - r) * q) + off; }
        const int nig = WGM * nN, gid = wgid / nig, fm = gid * WGM, gsz = (nM - fm) < WGM ? (nM - fm) : WGM;
        u.pm = fm + ((wgid % nig) % gsz); u.pn = (wgid % nig) / gsz; u.half = 0; return true;
    }
    __device__ __forceinline__ void a_ready(const Unit&) const {}
    __device__ __forceinline__ void done(const Unit&) const {}
};
struct HalfTailOrder : StaticOrder {
    bool use_half;
    __host__ __device__ __forceinline__ bool next(int i, Unit& u) const {
        const int nfr = nwg / G, rem = nwg - nfr * G;
        if (!use_half || rem == 0 || 2 * rem > G || (G & 15) != 0) return StaticOrder::next(i, u);
        if (i < nfr) return StaticOrder::next(i, u);
        if (i > nfr) return false;
        const int cc = (c & 7) | ((c >> 4) << 3), hs = (c >> 3) & 1;
        if (cc >= rem) return false;
        StaticOrder T = *this; T.c = cc;
        T.next(nfr, u); u.half = 1 + hs; return true;
    }
};
__device__ __forceinline__ unsigned cvt_pk_bf16(float lo, float hi) { unsigned r; asm volatile("v_cvt_pk_bf16_f32 %0, %1, %2" : "=v"(r) : "v"(lo), "v"(hi)); return r; }
typedef float f32x2 __attribute__((ext_vector_type(2)));
template <class Epi, class Sched, bool ALIGN_EPI = false, bool SP2 = false, bool HALFU = false>
__device__ __forceinline__ void gemm_phase(PG8_LAS unsigned char* lds, const Gemm g, const Sched& S, const Epi& E, const int wv) {
    int tid = tid_of(wv);
    int wid_ = wv; asm volatile("" : "+s"(wid_)); const int wid = wid_, lane = tid & 63, wr = wid >> 2, wc = wid & 3, fr = lane & 15, fq = lane >> 4;
    int K = g.K; asm volatile("" : "+s"(K)); const int nt = K / BK;
    unsigned voffA[2], voffB[2];
#pragma unroll
    for (int i = 0; i < 2; ++i) { int R, C; stage_rc(tid * 16 + i * 8192, R, C); const int Rb = Epi::PERM ? ((R & ~31) + perm32(R & 31)) : R;
        voffA[i] = (unsigned)(R * K + C) * 2u; voffB[i] = (unsigned)(Rb * K + C) * 2u; }
    const size_t kstep = (size_t)(BK * 2);
    const size_t hstep = (size_t)HALF * K * 2;
    const size_t tstep = 2 * hstep;
    const unsigned ldsw = (unsigned)wid * 1024u;
    const int aoff = lds_byte(wr * 64 + fr, fq * 8), boff = lds_byte(wc * 32 + fr, fq * 8);
#define PG8_SA(b, h) (((b) * 2 + (h)) * HTB)
#define PG8_SB(b, h) ((4 + (b) * 2 + (h)) * HTB)
#define PG8_STAGE(bufoff, gbase, voff) do { _Pragma("unroll") for (int _i = 0; _i < 2; ++_i) \
        __builtin_amdgcn_global_load_lds((const unsigned*)((const char*)(gbase) + (voff)[_i]), (PG8_LAS unsigned*)(lds + (bufoff) + ldsw + _i * 8192), 16, 0, 0); } while (0)
#define PG8_LDA(dst, b, h) do { _Pragma("unroll") for (int m = 0; m < 4; ++m) _Pragma("unroll") for (int k = 0; k < 2; ++k) dst[m][k] = *(const PG8_LAS bf16x8*)(lds + PG8_SA(b, h) + aoff + m * 2048 + k * 1024); } while (0)
#define PG8_LDB(dst, b, h) do { _Pragma("unroll") for (int n = 0; n < 2; ++n) _Pragma("unroll") for (int k = 0; k < 2; ++k) dst[n][k] = *(const PG8_LAS bf16x8*)(lds + PG8_SB(b, h) + boff + n * 2048 + k * 1024); } while (0)
#define PG8_MMA(ai, bj, At, Bt) do { __builtin_amdgcn_s_setprio(1); _Pragma("unroll") for (int m = 0; m < 4; ++m) _Pragma("unroll") for (int n = 0; n < 2; ++n) _Pragma("unroll") for (int k = 0; k < 2; ++k) \
        acc[ai][bj][m][n] = __builtin_amdgcn_mfma_f32_16x16x32_bf16(Bt[n][k], At[m][k], acc[ai][bj][m][n], 0, 0, 0); __builtin_amdgcn_s_setprio(0); } while (0)
#define PG8_WAIT_V(n) asm volatile("s_waitcnt vmcnt(" #n ")" ::: "memory")
#define PG8_WAIT_L(n) asm volatile("s_waitcnt lgkmcnt(" #n ")" ::: "memory")
#define PG8_BAR __builtin_amdgcn_s_barrier()
#define PG8_SCHED __builtin_amdgcn_sched_barrier(0)
    Unit cur, nxt; int ui = 0;
    if (!S.next(0, cur)) return;
    f32x4 acc[2][2][4][2];
    u32x4 ini[2][4][2];
    if constexpr (Epi::PRE) E.pre_load(ini, cur, tid);
    if constexpr (Epi::INIT_ACC) E.init_load(ini, cur, wr, wc, fr, fq);
    else {
#pragma unroll
    for (int a = 0; a < 2; ++a)
#pragma unroll
        for (int b = 0; b < 2; ++b)
#pragma unroll
            for (int m = 0; m < 4; ++m)
#pragma unroll
                for (int n = 0; n < 2; ++n) acc[a][b][m][n] = (f32x4){0.f, 0.f, 0.f, 0.f};
    }
    bf16x8 At[4][2], B0[2][2], B1[2][2];
    const char* cA = (const char*)g.A + (size_t)cur.pm * tstep + (cur.half == 2 ? hstep : (size_t)0); bool full = HALFU ? (cur.half == 0) : true; const char* cB = (const char*)g.Bt + (size_t)cur.pn * tstep;
    S.a_ready(cur);
    if constexpr (SP2) {
        PG8_STAGE(PG8_SB(0, 0), cB, voffB); PG8_STAGE(PG8_SB(0, 1), cB + hstep, voffB); PG8_STAGE(PG8_SA(0, 0), cA, voffA); PG8_STAGE(PG8_SA(0, 1), cA + hstep, voffA);
        if constexpr (Epi::PRE) E.pre_finish(ini, tid);
        if constexpr (Epi::INIT_ACC) E.init_finish(acc, ini);
        if (wr == 1) PG8_BAR;
        PG8_WAIT_V(2); PG8_BAR;
        PG8_STAGE(PG8_SB(1, 0), cB + kstep, voffB); PG8_STAGE(PG8_SA(1, 0), cA + kstep, voffA); PG8_STAGE(PG8_SB(1, 1), cB + hstep + kstep, voffB);
        PG8_WAIT_V(6); PG8_BAR;
    } else {
        PG8_STAGE(PG8_SB(0, 0), cB, voffB); PG8_STAGE(PG8_SA(0, 0), cA, voffA); PG8_STAGE(PG8_SB(0, 1), cB + hstep, voffB); PG8_STAGE(PG8_SA(0, 1), cA + hstep, voffA);
        if (wr == 1) PG8_BAR;
        PG8_WAIT_V(4); PG8_BAR;
        PG8_STAGE(PG8_SB(1, 0), cB + kstep, voffB); PG8_STAGE(PG8_SA(1, 0), cA + kstep, voffA); PG8_STAGE(PG8_SB(1, 1), cB + hstep + kstep, voffB);
        PG8_WAIT_V(6); PG8_BAR;
    }
    for (;;) {
        const bool has_next = S.next(ui + 1, nxt);
        const char* nA = has_next ? (const char*)g.A + (size_t)nxt.pm * tstep + (nxt.half == 2 ? hstep : (size_t)0) : cA; const char* nB = has_next ? (const char*)g.Bt + (size_t)nxt.pn * tstep : cB;
        for (int t = 0; t < nt; t += 2) {
            const bool last = (t == nt - 2);
            const char* a1 = cA + (size_t)(t + 1) * kstep;
            const char* a2 = last ? nA : cA + (size_t)(t + 2) * kstep; const char* b2 = last ? nB : cB + (size_t)(t + 2) * kstep;
            const char* a3 = a2 + kstep; const char* b3 = b2 + kstep;
            if (last && has_next) S.a_ready(nxt);
            if constexpr (SP2) {
            PG8_LDB(B0, 0, 0); PG8_LDB(B1, 0, 1); PG8_SCHED; PG8_LDA(At, 0, 0); PG8_STAGE(PG8_SA(1, 1), a1 + hstep, voffA);
            PG8_WAIT_V(8); PG8_WAIT_L(0); PG8_BAR; PG8_MMA(0, 0, At, B0); PG8_MMA(0, 1, At, B1); PG8_BAR; PG8_SCHED;
            if (!HALFU || full) PG8_LDA(At, 0, 1); PG8_STAGE(PG8_SB(0, 0), b2, voffB); PG8_STAGE(PG8_SB(0, 1), b2 + hstep, voffB); PG8_STAGE(PG8_SA(0, 0), a2, voffA);
            PG8_WAIT_V(8); PG8_WAIT_L(0); PG8_BAR; if (!HALFU || full) { PG8_MMA(1, 0, At, B0); PG8_MMA(1, 1, At, B1); } PG8_BAR; PG8_SCHED;
            PG8_LDB(B0, 1, 0); PG8_LDB(B1, 1, 1); PG8_SCHED; PG8_LDA(At, 1, 0); PG8_STAGE(PG8_SA(0, 1), a2 + hstep, voffA);
            PG8_WAIT_V(8); PG8_WAIT_L(0); PG8_BAR; PG8_MMA(0, 0, At, B0); PG8_MMA(0, 1, At, B1); PG8_BAR; PG8_SCHED;
            if (!HALFU || full) PG8_LDA(At, 1, 1); PG8_STAGE(PG8_SB(1, 0), b3, voffB); PG8_STAGE(PG8_SB(1, 1), b3 + hstep, voffB); PG8_STAGE(PG8_SA(1, 0), a3, voffA);
            PG8_WAIT_V(8); PG8_WAIT_L(0); PG8_BAR; if (!HALFU || full) { PG8_MMA(1, 0, At, B0); PG8_MMA(1, 1, At, B1); } PG8_BAR; PG8_SCHED;
            } else {
            PG8_LDB(B0, 0, 0); PG8_SCHED; PG8_LDA(At, 0, 0); PG8_STAGE(PG8_SA(1, 1), a1 + hstep, voffA);
            PG8_WAIT_L(8); PG8_BAR; PG8_WAIT_L(0); PG8_MMA(0, 0, At, B0); PG8_BAR; PG8_SCHED;
            PG8_LDB(B1, 0, 1); PG8_STAGE(PG8_SB(0, 0), b2, voffB);
            PG8_BAR; PG8_WAIT_L(0); PG8_MMA(0, 1, At, B1); PG8_BAR;
            PG8_LDA(At, 0, 1); PG8_STAGE(PG8_SA(0, 0), a2, voffA);
            PG8_BAR; PG8_WAIT_L(0); PG8_MMA(1, 0, At, B0); PG8_BAR; PG8_SCHED;
            PG8_STAGE(PG8_SB(0, 1), b2 + hstep, voffB);
            PG8_WAIT_V(6); PG8_BAR; PG8_MMA(1, 1, At, B1); PG8_BAR;
            PG8_LDB(B0, 1, 0); PG8_SCHED; PG8_LDA(At, 1, 0); PG8_STAGE(PG8_SA(0, 1), a2 + hstep, voffA);
            PG8_WAIT_L(8); PG8_BAR; PG8_WAIT_L(0); PG8_MMA(0, 0, At, B0); PG8_BAR; PG8_SCHED;
            PG8_LDB(B1, 1, 1); PG8_STAGE(PG8_SB(1, 0), b3, voffB);
            PG8_BAR; PG8_WAIT_L(0); PG8_MMA(0, 1, At, B1); PG8_BAR;
            PG8_LDA(At, 1, 1); PG8_STAGE(PG8_SA(1, 0), a3, voffA);
            PG8_BAR; PG8_WAIT_L(0); PG8_MMA(1, 0, At, B0); PG8_BAR; PG8_SCHED;
            PG8_STAGE(PG8_SB(1, 1), b3 + hstep, voffB);
            PG8_WAIT_V(6); PG8_BAR; PG8_MMA(1, 1, At, B1); PG8_BAR;
            }
        }
        if constexpr (ALIGN_EPI) { if (wr == 0) PG8_BAR; }
        if constexpr (!Epi::AFTER_DRAIN) { E(acc, cur, wr, wc, fr, fq); S.done(cur); }
        if (!has_next) break;
#pragma unroll
        for (int a = 0; a < 2; ++a)
#pragma unroll
            for (int b = 0; b < 2; ++b)
#pragma unroll
                for (int m = 0; m < 4; ++m)
#pragma unroll
                    for (int n = 0; n < 2; ++n) acc[a][b][m][n] = (f32x4){0.f, 0.f, 0.f, 0.f};
        if constexpr (Epi::INIT_ACC) { E.init_load(ini, nxt, wr, wc, fr, fq); E.init_finish(acc, ini); }
        cur = nxt; cA = nA; cB = nB; ++ui; full = HALFU ? (cur.half == 0) : true;
        if constexpr (ALIGN_EPI) { if (wr == 1) PG8_BAR; }
    }
    PG8_WAIT_V(0);
    if constexpr (!ALIGN_EPI) { if (wr == 0) PG8_BAR; }
    PG8_BAR;
    if constexpr (Epi::AFTER_DRAIN) { E.fused(acc, cur, wr, wc, fr, fq, lds, wid, lane); S.done(cur); }
#undef PG8_SA
#undef PG8_SB
#undef PG8_STAGE
#undef PG8_LDA
#undef PG8_LDB
#undef PG8_MMA
#undef PG8_WAIT_V
#undef PG8_WAIT_L
#undef PG8_BAR
#undef PG8_SCHED
}
}
namespace pg8 {
typedef float f32x2v __attribute__((ext_vector_type(2)));
constexpr float RMS_EPS = 1e-6f;
constexpr float LOG2E = 1.4426950408889634f;
__device__ __forceinline__ unsigned pkbf(float lo, float hi) { typedef __bf16 bf2 __attribute__((ext_vector_type(2))); f32x2v v = {lo, hi}; bf2 b = __builtin_convertvector(v, bf2); return __builtin_bit_cast(unsigned, b); }
__device__ __forceinline__ u32x4 pk8(const f32x4 a, const f32x4 b) { u32x4 w; w.x = pkbf(a[0], a[1]); w.y = pkbf(a[2], a[3]); w.z = pkbf(b[0], b[1]); w.w = pkbf(b[2], b[3]); return w; }
__device__ __forceinline__ float sum4sq(const f32x4 a) { return (a[0] * a[0] + a[1] * a[1]) + (a[2] * a[2] + a[3] * a[3]); }
__device__ __forceinline__ float red_fq(float s) { s += __shfl_xor(s, 16); s += __shfl_xor(s, 32); return s; }
__device__ __forceinline__ void load_rstd16(const float* ssp, int row0, int fq, float (&rs)[2][4]) {
    f32x4 v[2][4];
#pragma unroll
    for (int ai = 0; ai < 2; ++ai)
#pragma unroll
        for (int m = 0; m < 4; ++m) v[ai][m] = *(const f32x4*)(ssp + (size_t)(row0 + ai * HALF + m * 16) * 16 + 4 * fq);
    asm volatile("" : "+v"(v[0][0]), "+v"(v[0][1]), "+v"(v[0][2]), "+v"(v[0][3]), "+v"(v[1][0]), "+v"(v[1][1]), "+v"(v[1][2]), "+v"(v[1][3]));
#pragma unroll
    for (int ai = 0; ai < 2; ++ai)
#pragma unroll
        for (int m = 0; m < 4; ++m) { const float s = red_fq((v[ai][m][0] + v[ai][m][1]) + (v[ai][m][2] + v[ai][m][3])); rs[ai][m] = rsqrtf(s * (1.0f / 1024.0f) + RMS_EPS); }
}
__device__ __forceinline__ void load_rstd4(const float* part, int row0, float inv_n, float (&rs)[2][4]) {
    f32x4 v[2][4];
#pragma unroll
    for (int ai = 0; ai < 2; ++ai)
#pragma unroll
        for (int m = 0; m < 4; ++m) v[ai][m] = *(const f32x4*)(part + (size_t)(row0 + ai * HALF + m * 16) * 4);
    asm volatile("" : "+v"(v[0][0]), "+v"(v[0][1]), "+v"(v[0][2]), "+v"(v[0][3]), "+v"(v[1][0]), "+v"(v[1][1]), "+v"(v[1][2]), "+v"(v[1][3]));
#pragma unroll
    for (int ai = 0; ai < 2; ++ai)
#pragma unroll
        for (int m = 0; m < 4; ++m) rs[ai][m] = rsqrtf(((v[ai][m][0] + v[ai][m][1]) + (v[ai][m][2] + v[ai][m][3])) * inv_n + RMS_EPS);
}
__device__ __forceinline__ float rstd16(const float* ssp, int r, int fq) { const f32x4 v = *(const f32x4*)(ssp + (size_t)r * 16 + 4 * fq); const float s = red_fq((v[0] + v[1]) + (v[2] + v[3])); return rsqrtf(s * (1.0f / 1024.0f) + RMS_EPS); }
__device__ __forceinline__ float rstd4(const float* part, int r, float inv_n) { const f32x4 v = *(const f32x4*)(part + (size_t)r * 4); return rsqrtf(((v[0] + v[1]) + (v[2] + v[3])) * inv_n + RMS_EPS); }
__device__ __forceinline__ void tbl_load16(u32x4 (&ini)[2][4][2], const float* ssp, int prow, int tid) {
    if (tid < 256) { const u32x4* sp = (const u32x4*)(ssp + (size_t)(prow + tid) * 16); ini[0][0][0] = sp[0]; ini[0][0][1] = sp[1]; ini[0][1][0] = sp[2]; ini[0][1][1] = sp[3]; } }
__device__ __forceinline__ void tbl_fin16(const u32x4 (&ini)[2][4][2], PG8_LAS float* rsl, int tid) {
    if (tid < 256) { const f32x4 s0 = __builtin_bit_cast(f32x4, ini[0][0][0]), s1 = __builtin_bit_cast(f32x4, ini[0][0][1]), s2 = __builtin_bit_cast(f32x4, ini[0][1][0]), s3 = __builtin_bit_cast(f32x4, ini[0][1][1]);
        const float sm = ((s0[0] + s0[1]) + (s0[2] + s0[3])) + ((s1[0] + s1[1]) + (s1[2] + s1[3])) + ((s2[0] + s2[1]) + (s2[2] + s2[3])) + ((s3[0] + s3[1]) + (s3[2] + s3[3]));
        rsl[tid] = rsqrtf(sm * (1.0f / 1024.0f) + RMS_EPS); } }
__device__ __forceinline__ void tbl_load4(u32x4 (&ini)[2][4][2], const float* part, int prow, int tid) { if (tid < 256) ini[0][0][0] = *(const u32x4*)(part + (size_t)(prow + tid) * 4); }
__device__ __forceinline__ void tbl_fin4(const u32x4 (&ini)[2][4][2], PG8_LAS float* rsl, float inv_n, int tid) {
    if (tid < 256) { const f32x4 v = __builtin_bit_cast(f32x4, ini[0][0][0]); rsl[tid] = rsqrtf(((v[0] + v[1]) + (v[2] + v[3])) * inv_n + RMS_EPS); } }
__device__ __forceinline__ void tbl_get(const PG8_LAS float* rsl, int rl0, float (&rs)[2][4]) {
#pragma unroll
    for (int ai = 0; ai < 2; ++ai)
#pragma unroll
        for (int m = 0; m < 4; ++m) rs[ai][m] = rsl[(rl0 + ai * HALF + m * 16) & 255]; }
struct EpiSwiGLU {
    static constexpr bool PERM = true, AFTER_DRAIN = false, INIT_ACC = false, PRE = true;
    bf16_t* H; int ldh; PG8_LAS float* rsl; const float* ssp;
    __device__ __forceinline__ void pre_load(u32x4 (&ini)[2][4][2], const Unit& u, int tid) const { tbl_load16(ini, ssp, u.pm * BM, tid); }
    __device__ __forceinline__ void pre_finish(const u32x4 (&ini)[2][4][2], int tid) const { tbl_fin16(ini, rsl, tid); }
    __device__ __forceinline__ void operator()(const f32x4 (&acc)[2][2][4][2], const Unit& u, int wr, int wc, int fr, int fq) const {
        asm volatile("" : "+v"(fr), "+v"(fq));
        const int nai = u.half ? 1 : 2; const int row0 = u.pm * BM + (u.half == 2 ? HALF : 0) + wr * 64 + fr, col0 = u.pn * HALF + wc * 32 + 8 * fq;
        const int rl0 = (u.half == 2 ? HALF : 0) + wr * 64 + fr;
        const __amdgpu_buffer_rsrc_t hrs = __builtin_amdgcn_make_buffer_rsrc((void*)H, 0, 0x7ffffff0, 0x00020000);
#pragma unroll
        for (int ai = 0; ai < 2; ++ai) if (ai < nai)
#pragma unroll
            for (int m = 0; m < 4; ++m) { const float r = rsl[rl0 + ai * HALF + m * 16]; f32x4 a[2]; const float c = -LOG2E * r, r2 = r * r;
#pragma unroll
                for (int n = 0; n < 2; ++n) { const f32x4 G = acc[ai][0][m][n], t = G * c, gu = G * acc[ai][1][m][n]; f32x4 ex;
#pragma unroll
                    for (int e = 0; e < 4; ++e) ex[e] = __builtin_amdgcn_exp2f(t[e]);
                    const f32x4 d = ex + 1.0f; f32x4 q;
#pragma unroll
                    for (int e = 0; e < 4; ++e) q[e] = __builtin_amdgcn_rcpf(d[e]);
                    a[n] = (gu * q) * r2; }
                __builtin_amdgcn_raw_buffer_store_b128(pk8(a[0], a[1]), hrs, (unsigned)(((row0 + ai * HALF + m * 16) * ldh + col0) * 2), 0, 16); }
    }
};
struct EpiResid {
    static constexpr bool PERM = true, AFTER_DRAIN = false, INIT_ACC = true, PRE = false;
    const float* R; float* X; bf16_t* XB; float* ssp; float alpha; bool wx;
    __device__ __forceinline__ void init_load(u32x4 (&ini)[2][4][2], const Unit& u, int wr, int wc, int fr, int fq) const {
        asm volatile("" : "+v"(fr), "+v"(fq));
        const int row0 = u.pm * BM + wr * 64 + fr, col0 = u.pn * BM + wc * 32 + 8 * fq;
#pragma unroll
        for (int ai = 0; ai < 2; ++ai)
#pragma unroll
            for (int m = 0; m < 4; ++m)
#pragma unroll
                for (int bj = 0; bj < 2; ++bj) ini[ai][m][bj] = *(const u32x4*)(XB + (size_t)(row0 + ai * HALF + m * 16) * 1024 + col0 + bj * HALF);
    }
    __device__ __forceinline__ void init_finish(f32x4 (&acc)[2][2][4][2], const u32x4 (&ini)[2][4][2]) const {
        const float ia = alpha != 0.f ? 1.0f / alpha : 0.f;
#pragma unroll
        for (int ai = 0; ai < 2; ++ai)
#pragma unroll
            for (int m = 0; m < 4; ++m)
#pragma unroll
                for (int bj = 0; bj < 2; ++bj) { const u32x4 q = ini[ai][m][bj];
                    acc[ai][bj][m][0] = (f32x4){__uint_as_float(q.x << 16), __uint_as_float(q.x & 0xffff0000u), __uint_as_float(q.y << 16), __uint_as_float(q.y & 0xffff0000u)} * ia;
                    acc[ai][bj][m][1] = (f32x4){__uint_as_float(q.z << 16), __uint_as_float(q.z & 0xffff0000u), __uint_as_float(q.w << 16), __uint_as_float(q.w & 0xffff0000u)} * ia; }
    }
    __device__ __forceinline__ void operator()(const f32x4 (&acc)[2][2][4][2], const Unit& u, int wr, int wc, int fr, int fq) const {
        asm volatile("" : "+v"(fr), "+v"(fq));
        const int row0 = u.pm * BM + wr * 64 + fr, col0 = u.pn * BM + wc * 32 + 8 * fq;
#pragma unroll
        for (int ai = 0; ai < 2; ++ai)
#pragma unroll
            for (int m = 0; m < 4; ++m) { const int r = row0 + ai * HALF + m * 16; float ss = 0.f;
#pragma unroll
                for (int bj = 0; bj < 2; ++bj) { const size_t off = (size_t)r * 1024 + col0 + bj * HALF;
                    const f32x4 x0 = acc[ai][bj][m][0] * alpha, x1 = acc[ai][bj][m][1] * alpha;
                    if (wx) { *(f32x4*)(X + off) = x0; *(f32x4*)(X + off + 4) = x1; }
                    else { *(u32x4*)(XB + off) = pk8(x0, x1); ss += sum4sq(x0) + sum4sq(x1); } }
                if (!wx) { ss = red_fq(ss); if (fq == 0) ssp[(size_t)r * 16 + u.pn * 4 + wc] = ss; } }
    }
};
struct EpiQKV {
    static constexpr bool PERM = true, AFTER_DRAIN = false, INIT_ACC = false, PRE = true;
    bf16_t *Q, *K, *V; const float* ssp; const float *qg, *kg; float qsc; PG8_LAS float* rsl;
    __device__ __forceinline__ void pre_load(u32x4 (&ini)[2][4][2], const Unit& u, int tid) const { tbl_load16(ini, ssp, u.pm * BM, tid); }
    __device__ __forceinline__ void pre_finish(const u32x4 (&ini)[2][4][2], int tid) const { tbl_fin16(ini, rsl, tid); }
    __device__ __forceinline__ void operator()(const f32x4 (&acc)[2][2][4][2], const Unit& u, int wr, int wc, int fr, int fq) const {
        asm volatile("" : "+v"(fr), "+v"(fq));
        const int row0 = u.pm * BM + wr * 64 + fr;
        float rs[2][4]; tbl_get(rsl, wr * 64 + fr, rs);
        const bool isq = u.pn < 4, isv = (!isq) && wc >= 2;
        bf16_t* base = isq ? Q + (u.pn * 4 + wc) * 64 : (isv ? V + (wc - 2) * 64 : K + wc * 64); const int ld = isq ? 1024 : 128;
        const float* gp = isq ? qg : kg; const float gs = isq ? qsc : 1.0f;
        f32x4 g[2][2];
#pragma unroll
        for (int bj = 0; bj < 2; ++bj)
#pragma unroll
            for (int n = 0; n < 2; ++n) g[bj][n] = *(const f32x4*)(gp + 32 * bj + 8 * fq + 4 * n) * gs;
#pragma unroll
        for (int ai = 0; ai < 2; ++ai)
#pragma unroll
            for (int m = 0; m < 4; ++m) { const int r = row0 + ai * HALF + m * 16; const float rx = rs[ai][m]; f32x4 v[2][2]; float ss = 0.f;
#pragma unroll
                for (int bj = 0; bj < 2; ++bj)
#pragma unroll
                    for (int n = 0; n < 2; ++n) { v[bj][n] = acc[ai][bj][m][n] * rx; ss += sum4sq(v[bj][n]); }
                ss = red_fq(ss); const float rn = rsqrtf(ss * (1.0f / 64.0f) + RMS_EPS);
#pragma unroll
                for (int bj = 0; bj < 2; ++bj) { f32x4 a = v[bj][0], b = v[bj][1]; if (!isv) { a = a * g[bj][0] * rn; b = b * g[bj][1] * rn; }
                    *(u32x4*)(base + (size_t)r * ld + 32 * bj + 8 * fq) = pk8(a, b); } }
    }
};
__device__ __forceinline__ double rope_invf(int i) {
    switch (i) { case 0: return 1.0; case 1: return 0.5623413251903491; case 2: return 0.31622776601683794; case 3: return 0.1778279410038923; case 4: return 0.1; case 5: return 0.05623413251903491;
        case 6: return 0.03162277660168379; case 7: return 0.01778279410038923; case 8: return 0.01; case 9: return 0.005623413251903491; case 10: return 0.0031622776601683794; case 11: return 0.0017782794100389228;
        case 12: return 0.001; case 13: return 0.0005623413251903491; case 14: return 0.00031622776601683794; default: return 0.00017782794100389227; }
}
__device__ __forceinline__ void rope_cs(float posf, int i, float& cs, float& sn) {
    const float ang = posf * (float)rope_invf(i);
    double rev = (double)ang * 0.15915494309189535; rev -= __builtin_rint(rev);
    const float rf = (float)rev; cs = __builtin_amdgcn_cosf(rf); sn = __builtin_amdgcn_sinf(rf);
}
struct EpiBIn {
    static constexpr bool PERM = true, AFTER_DRAIN = false, INIT_ACC = false, PRE = true;
    bf16_t *Cq, *Ckv; float *ssq, *sskv, *ssr, *KR; const float* ssp; const float* cst  ; const float* kg; PG8_LAS float* rsl;
    __device__ __forceinline__ void pre_load(u32x4 (&ini)[2][4][2], const Unit& u, int tid) const { tbl_load16(ini, ssp, u.pm * BM, tid); }
    __device__ __forceinline__ void pre_finish(const u32x4 (&ini)[2][4][2], int tid) const { tbl_fin16(ini, rsl, tid); }
    __device__ __forceinline__ void operator()(const f32x4 (&acc)[2][2][4][2], const Unit& u, int wr, int wc, int fr, int fq) const {
        asm volatile("" : "+v"(fr), "+v"(fq));
        const int nai = u.half ? 1 : 2; const int row0 = u.pm * BM + (u.half == 2 ? HALF : 0) + wr * 64 + fr;
        float rs[2][4]; tbl_get(rsl, (u.half == 2 ? HALF : 0) + wr * 64 + fr, rs);
        if (u.pn == 0) {
#pragma unroll
            for (int ai = 0; ai < 2; ++ai) if (ai < nai)
#pragma unroll
                for (int m = 0; m < 4; ++m) { const int r = row0 + ai * HALF + m * 16; const float rx = rs[ai][m]; float ss = 0.f;
#pragma unroll
                    for (int bj = 0; bj < 2; ++bj) { const f32x4 a = acc[ai][bj][m][0] * rx, b = acc[ai][bj][m][1] * rx; ss += sum4sq(a) + sum4sq(b);
                        *(u32x4*)(Cq + (size_t)r * 256 + bj * HALF + wc * 32 + 8 * fq) = pk8(a, b); }
                    ss = red_fq(ss); if (fq == 0) ssq[(size_t)r * 4 + wc] = ss; }
        } else {
#pragma unroll
            for (int ai = 0; ai < 2; ++ai) if (ai < nai)
#pragma unroll
                for (int m = 0; m < 4; ++m) { const int r = row0 + ai * HALF + m * 16; const float rx = rs[ai][m];
                    const f32x4 a = acc[ai][0][m][0] * rx, b = acc[ai][0][m][1] * rx; float ss = red_fq(sum4sq(a) + sum4sq(b));
                    *(u32x4*)(Ckv + (size_t)r * 128 + wc * 32 + 8 * fq) = pk8(a, b);
                    if (fq == 0) sskv[(size_t)r * 4 + wc] = ss; }
            if (wc == 0) {
                const f32x4 g1 = *(const f32x4*)(kg + 64 + 4 * fq), g2 = *(const f32x4*)(kg + 80 + 4 * fq);
#pragma unroll
                for (int ai = 0; ai < 2; ++ai) if (ai < nai) {
                    f32x4 cs[4], sn[4];
#pragma unroll
                    for (int m = 0; m < 4; ++m) { const int r = row0 + ai * HALF + m * 16; cs[m] = *(const f32x4*)(cst + (size_t)r * 32 + 4 * fq); sn[m] = *(const f32x4*)(cst + (size_t)r * 32 + 16 + 4 * fq); }
                    asm volatile("" ::: "memory");
#pragma unroll
                    for (int m = 0; m < 4; ++m) { const int r = row0 + ai * HALF + m * 16; const float rx = rs[ai][m];
                        f32x4 t1 = acc[ai][1][m][0] * rx, t2 = acc[ai][1][m][1] * rx;
                        const float s2 = red_fq(sum4sq(t1) + sum4sq(t2)); if (fq == 0) ssr[r] = s2;
                        t1 = t1 * g1; t2 = t2 * g2;
                        const f32x4 o1 = t1 * cs[m] - t2 * sn[m], o2 = t2 * cs[m] + t1 * sn[m];
                        *(f32x4*)(KR + (size_t)r * 32 + 4 * fq) = o1; *(f32x4*)(KR + (size_t)r * 32 + 16 + 4 * fq) = o2; }
                    asm volatile("" ::: "memory"); } }
        }
    }
};
struct EpiUQ {
    static constexpr bool PERM = true, AFTER_DRAIN = false, INIT_ACC = false, PRE = true;
    bf16_t* QR; const float* ssq; PG8_LAS float* rsl;
    __device__ __forceinline__ void pre_load(u32x4 (&ini)[2][4][2], const Unit& u, int tid) const { tbl_load4(ini, ssq, u.pm * BM, tid); }
    __device__ __forceinline__ void pre_finish(const u32x4 (&ini)[2][4][2], int tid) const { tbl_fin4(ini, rsl, 1.0f / 256.0f, tid); }
    __device__ __forceinline__ void operator()(const f32x4 (&acc)[2][2][4][2], const Unit& u, int wr, int wc, int fr, int fq) const {
        asm volatile("" : "+v"(fr), "+v"(fq));
        const int nai = u.half ? 1 : 2; const int row0 = u.pm * BM + (u.half == 2 ? HALF : 0) + wr * 64 + fr, col0 = u.pn * BM + wc * 32 + 8 * fq;
        float rs[2][4]; tbl_get(rsl, (u.half == 2 ? HALF : 0) + wr * 64 + fr, rs);
#pragma unroll
        for (int ai = 0; ai < 2; ++ai) if (ai < nai)
#pragma unroll
            for (int m = 0; m < 4; ++m) { const int r = row0 + ai * HALF + m * 16; const float rx = rs[ai][m];
#pragma unroll
                for (int bj = 0; bj < 2; ++bj) *(u32x4*)(QR + (size_t)r * 1536 + col0 + bj * HALF) = pk8(acc[ai][bj][m][0] * rx, acc[ai][bj][m][1] * rx); }
    }
};
struct EpiUKV {
    static constexpr bool PERM = true, AFTER_DRAIN = false, INIT_ACC = false, PRE = true;
    bf16_t *KF, *VF; const float *sskv, *ssr, *KR; PG8_LAS float* rsl;
    __device__ __forceinline__ void pre_load(u32x4 (&ini)[2][4][2], const Unit& u, int tid) const { tbl_load4(ini, sskv, u.pm * BM, tid); }
    __device__ __forceinline__ void pre_finish(const u32x4 (&ini)[2][4][2], int tid) const { tbl_fin4(ini, rsl, 1.0f / 128.0f, tid); }
    __device__ __forceinline__ void operator()(const f32x4 (&acc)[2][2][4][2], const Unit& u, int wr, int wc, int fr, int fq) const {
        asm volatile("" : "+v"(fr), "+v"(fq));
        const int row0 = u.pm * BM + wr * 64 + fr;
        float rs[2][4]; tbl_get(rsl, wr * 64 + fr, rs);
        if (u.pn < 4) {
            const int head = u.pn * 4 + wc;
#pragma unroll
            for (int ai = 0; ai < 2; ++ai) {
                float sr[4]; f32x4 kr[4][2];
#pragma unroll
                for (int m = 0; m < 4; ++m) { const int r = row0 + ai * HALF + m * 16; sr[m] = ssr[r]; kr[m][0] = *(const f32x4*)(KR + (size_t)r * 32 + 8 * fq); kr[m][1] = *(const f32x4*)(KR + (size_t)r * 32 + 8 * fq + 4); }
                asm volatile("" ::: "memory");
#pragma unroll
                for (int m = 0; m < 4; ++m) { const int r = row0 + ai * HALF + m * 16; const float rx = rs[ai][m]; f32x4 v[2][2]; float ss = 0.f;
#pragma unroll
                    for (int bj = 0; bj < 2; ++bj)
#pragma unroll
                        for (int n = 0; n < 2; ++n) { v[bj][n] = acc[ai][bj][m][n] * rx; ss += sum4sq(v[bj][n]); }
                    ss = red_fq(ss) + sr[m]; const float rk = rsqrtf(ss * (1.0f / 96.0f) + RMS_EPS);
                    bf16_t* kp = KF + (size_t)r * 1536 + head * 96;
#pragma unroll
                    for (int bj = 0; bj < 2; ++bj) *(u32x4*)(kp + 32 * bj + 8 * fq) = pk8(v[bj][0] * rk, v[bj][1] * rk);
                    *(u32x4*)(kp + 64 + 8 * fq) = pk8(kr[m][0] * rk, kr[m][1] * rk); }
                asm volatile("" ::: "memory"); }
        } else {
            const int head = (u.pn - 4) * 4 + wc;
#pragma unroll
            for (int ai = 0; ai < 2; ++ai)
#pragma unroll
                for (int m = 0; m < 4; ++m) { const int r = row0 + ai * HALF + m * 16; const float rx = rs[ai][m];
#pragma unroll
                    for (int bj = 0; bj < 2; ++bj) *(u32x4*)(VF + (size_t)r * 1024 + head * 64 + 32 * bj + 8 * fq) = pk8(acc[ai][bj][m][0] * rx, acc[ai][bj][m][1] * rx); }
        }
    }
};
}
namespace att {
#define ALAS __attribute__((address_space(3)))
typedef unsigned short bf16_t;
typedef short bf16x8 __attribute__((ext_vector_type(8)));
typedef short s16x4 __attribute__((ext_vector_type(4)));
typedef float f32x16 __attribute__((ext_vector_type(16)));
typedef float f32x4 __attribute__((ext_vector_type(4)));
typedef unsigned u32x4 __attribute__((ext_vector_type(4)));
constexpr int SEQ = 2048;
constexpr float NEGBIG = -1e30f;
constexpr float LOG2E = 1.4426950408889634f;
__device__ __forceinline__ int crow(int r, int hi) { return (r & 3) + 8 * (r >> 2) + 4 * hi; }
__device__ __forceinline__ unsigned pkbf(float lo, float hi) { typedef float f2 __attribute__((ext_vector_type(2))); typedef __bf16 bf2 __attribute__((ext_vector_type(2))); f2 v = {lo, hi}; bf2 b = __builtin_convertvector(v, bf2); return __builtin_bit_cast(unsigned, b); }
__device__ __forceinline__ s16x4 vtr(const ALAS char* p) { typedef short v4i16_t __attribute__((ext_vector_type(4))); return __builtin_bit_cast(s16x4, __builtin_amdgcn_ds_read_tr16_b64_v4i16((ALAS v4i16_t*)p)); }
__device__ __forceinline__ bf16x8 pack8(const f32x16& p, int b) { u32x4 w; w.x = pkbf(p[b], p[b + 1]); w.y = pkbf(p[b + 2], p[b + 3]); w.z = pkbf(p[b + 4], p[b + 5]); w.w = pkbf(p[b + 6], p[b + 7]); return __builtin_bit_cast(bf16x8, w); }
__device__ __forceinline__ float xhalf_max(float v) { auto r = __builtin_amdgcn_permlane32_swap(__float_as_uint(v), __float_as_uint(v), false, false); return fmaxf(__uint_as_float(r[0]), __uint_as_float(r[1])); }
__device__ __forceinline__ float xhalf_sum(float v) { auto r = __builtin_amdgcn_permlane32_swap(__float_as_uint(v), __float_as_uint(v), false, false); return __uint_as_float(r[0]) + __uint_as_float(r[1]); }
#define LDSW() asm volatile("s_waitcnt lgkmcnt(0)" ::: "memory")
__device__ __forceinline__ void store_o(const f32x16 (&o)[2], float linv, ALAS float* wsf, ALAS bf16_t* stg, bf16_t* Og, int ldo, int lane) {
    const int r32 = lane & 31, hi = lane >> 5;
    LDSW(); if (hi == 0) wsf[r32] = linv; LDSW();
#pragma unroll
    for (int g = 0; g < 4; ++g) { const f32x4 f = *(const ALAS f32x4*)(wsf + 8 * g + 4 * hi);
#pragma unroll
        for (int e = 0; e < 4; ++e) { const int reg = 4 * g + e, orow = 8 * g + 4 * hi + e;
#pragma unroll
            for (int dh = 0; dh < 2; ++dh) { const unsigned w = pkbf(o[dh][reg] * f[e], 0.f); stg[orow * 64 + dh * 32 + r32] = (bf16_t)(w & 0xffffu); } } }
    LDSW();
#pragma unroll
    for (int i = 0; i < 4; ++i) { const int row = i * 8 + (lane >> 3), ch = lane & 7; const u32x4 v = *(const ALAS u32x4*)(stg + row * 64 + ch * 8); *(u32x4*)(Og + (size_t)row * ldo + ch * 8) = v; }
    LDSW();
}
__device__ __forceinline__ void rescale_o(f32x16 (&o)[2], float f, ALAS float* wsf, int lane) {
    const int r32 = lane & 31, hi = lane >> 5;
    LDSW(); if (hi == 0) wsf[r32] = f; LDSW();
#pragma unroll
    for (int g = 0; g < 4; ++g) { const f32x4 v = *(const ALAS f32x4*)(wsf + 8 * g + 4 * hi);
#pragma unroll
        for (int e = 0; e < 4; ++e) { o[0][4 * g + e] *= v[e]; o[1][4 * g + e] *= v[e]; } }
    LDSW();
}
__device__ __forceinline__ int t5_bucket(int n) {
    if (n < 16) return n;
    float t = __logf((float)n / 16.f); t = t / 2.0794415416798357f; t = t * 16.f;
    const int l = 16 + (int)t; return l < 31 ? l : 31;
}

constexpr int A_K = 0, A_V = 32768, A_POS = 65536, A_TAB = 66560, A_WSF = 70912, A_OST = 72960, A_END = A_OST + 8 * 4096;
struct AttnA { const bf16_t *Q, *K, *V; bf16_t* O; const int* pos; const float* rel_bias; const float* sinks; };
__device__ __forceinline__ void attnA_unit(ALAS char* lds, const AttnA& T, int b, int blk, int kvh, int wv) {
    int tid = tid_of(wv); const int lane = tid & 63, r32 = lane & 31, hi = lane >> 5; int w_ = wv; asm volatile("" : "+s"(w_)); const int w = w_;
    const int row0 = b * SEQ + blk * 128;
    __syncthreads();
    {
      u32x4 kv[4], vv[4];
#pragma unroll
      for (int it = 0; it < 4; ++it) { const int q = tid + 512 * it; const int key = q & 255, c = q >> 8; const int rr = (blk > 0 || key >= 128) ? row0 - 128 + key : row0;
          kv[it] = *(const u32x4*)(T.K + (size_t)rr * 128 + kvh * 64 + c * 8); }
#pragma unroll
      for (int it = 0; it < 4; ++it) { const int q = tid + 512 * it; const int dh = q >> 10, kg = (q >> 6) & 15, kin = (q >> 2) & 15, ch = q & 3, key = kg * 16 + kin; const int rr = (blk > 0 || key >= 128) ? row0 - 128 + key : row0;
          vv[it] = *(const u32x4*)(T.V + (size_t)rr * 128 + kvh * 64 + dh * 32 + ch * 8); }
      const int pidx = (blk > 0 || (tid & 255) >= 128) ? row0 - 128 + (tid & 255) : row0; const int pv = T.pos[pidx];
      float tb[3];
#pragma unroll
      for (int i = 0; i < 3; ++i) { int q = tid + 512 * i; q = q < 8 * 129 ? q : 8 * 129 - 1; const int g = q / 129, n = q - g * 129; tb[i] = T.rel_bias[t5_bucket(n) * 16 + kvh * 8 + g]; }
      asm volatile("" ::: "memory");
      const u32x4 z4 = (u32x4){0u, 0u, 0u, 0u};
#pragma unroll
      for (int it = 0; it < 4; ++it) { const int q = tid + 512 * it; const int key = q & 255, c = q >> 8; *(ALAS u32x4*)(lds + A_K + c * 4096 + key * 16) = (blk > 0 || key >= 128) ? kv[it] : z4; }
#pragma unroll
      for (int it = 0; it < 4; ++it) { const int q = tid + 512 * it; const int key = ((q >> 6) & 15) * 16 + ((q >> 2) & 15); *(ALAS u32x4*)(lds + A_V + q * 16) = (blk > 0 || key >= 128) ? vv[it] : z4; }
      if (tid < 256) ((ALAS int*)(lds + A_POS))[tid] = (blk > 0 || tid >= 128) ? pv : 0;
#pragma unroll
      for (int i = 0; i < 3; ++i) { const int q = tid + 512 * i; if (q < 8 * 129) { const int g = q / 129, n = q - g * 129; ((ALAS float*)(lds + A_TAB))[g * 136 + n] = tb[i] * LOG2E; } } }
    __syncthreads();
    const int h = kvh * 8 + w; const float sink2 = T.sinks[h] * LOG2E;
    const ALAS float* tab = (const ALAS float*)(lds + A_TAB) + w * 136; const ALAS int* posb = (const ALAS int*)(lds + A_POS);
    bool regular; { const int i0 = (blk > 0 ? 0 : 128) + (blk > 0 ? 4 : 2) * lane;
      bool ok = true;
#pragma unroll
      for (int e = 0; e < 4; ++e) { const int i = i0 + e; if ((blk > 0 || e < 2) && i + 1 < 256) ok = ok && (posb[i + 1] - posb[i] == 1); }
      regular = __all(ok); }
    const ALAS float* tabq = tab + (128 + r32 - 4 * hi);
    ALAS float* wsf = (ALAS float*)(lds + A_WSF) + w * 64; ALAS bf16_t* stg = (ALAS bf16_t*)(lds + A_OST + w * 4096);
    const ALAS char* vbase = lds + A_V + ((lane >> 4) & 1) * 32 + (lane & 3) * 8 + (4 * hi + ((lane & 15) >> 2)) * 64;
    bf16x8 qn[4];
#pragma unroll
    for (int d0 = 0; d0 < 4; ++d0) qn[d0] = *(const bf16x8*)(T.Q + (size_t)(row0 + r32) * 1024 + h * 64 + d0 * 16 + hi * 8);
    for (int qt = 0; qt < 4; ++qt) {
        bf16x8 qr[4];
#pragma unroll
        for (int d0 = 0; d0 < 4; ++d0) qr[d0] = qn[d0];
        { const int qnrow = row0 + 32 * (qt < 3 ? qt + 1 : 3) + r32;
#pragma unroll
          for (int d0 = 0; d0 < 4; ++d0) qn[d0] = *(const bf16x8*)(T.Q + (size_t)qnrow * 1024 + h * 64 + d0 * 16 + hi * 8); }
        const int posq = posb[128 + 32 * qt + r32];
        f32x16 s[5]; float mx = NEGBIG;
#pragma unroll
        for (int t5 = 0; t5 < 5; ++t5) { const int kt = qt + t5;
            if (blk == 0 && kt < 4) {
#pragma unroll
                for (int r = 0; r < 16; ++r) s[t5][r] = NEGBIG;
            } else {
                f32x16 a = {};
#pragma unroll
                for (int d0 = 0; d0 < 4; ++d0) { const bf16x8 kf = *(const ALAS bf16x8*)(lds + A_K + (2 * d0 + hi) * 4096 + (32 * kt + r32) * 16); a = __builtin_amdgcn_mfma_f32_32x32x16_bf16(kf, qr[d0], a, 0, 0, 0); }
                asm volatile("s_nop 15\n\ts_nop 7" : "+v"(a));
                if (regular) {
#pragma unroll
                    for (int r = 0; r < 16; ++r) { const int kl = crow(r, hi);
                        const bool valid = (t5 == 0) ? (kl > r32) : ((t5 == 4) ? (kl <= r32) : true);
                        float bv = tabq[-(32 * t5 + (r & 3) + 8 * (r >> 2))];
                        asm volatile("" : "+v"(bv));
                        const float v = valid ? a[r] + bv : NEGBIG; a[r] = v; mx = fmaxf(mx, v); }
                } else {
#pragma unroll
                    for (int r = 0; r < 16; ++r) { const int kl = crow(r, hi); int n = posq - posb[32 * kt + kl]; n = n < 0 ? 0 : (n > 128 ? 128 : n);
                        const bool valid = (t5 == 0) ? (kl > r32) : ((t5 == 4) ? (kl <= r32) : true);
                        const float v = valid ? a[r] + tab[n] : NEGBIG; a[r] = v; mx = fmaxf(mx, v); } }
                s[t5] = a; } }
        mx = fmaxf(xhalf_max(mx), sink2);
        float l = 0.f;
#pragma unroll
        for (int t5 = 0; t5 < 5; ++t5)
#pragma unroll
            for (int r = 0; r < 16; ++r) { const float p = __builtin_amdgcn_exp2f(s[t5][r] - mx); s[t5][r] = p; l += p; }
        l = xhalf_sum(l) + __builtin_amdgcn_exp2f(sink2 - mx);
        f32x16 o[2]; o[0] = f32x16{}; o[1] = f32x16{};
#pragma unroll
        for (int t5 = 0; t5 < 5; ++t5) { const int kt = qt + t5;
            if (!(blk == 0 && kt < 4)) {
#pragma unroll
                for (int ks = 0; ks < 2; ++ks) { const bf16x8 pa = pack8(s[t5], 8 * ks);
#pragma unroll
                    for (int dh = 0; dh < 2; ++dh) { const ALAS char* vp = vbase + dh * 16384 + (2 * kt + ks) * 1024; const s16x4 lo = vtr(vp), hh = vtr(vp + 512);
                        const bf16x8 vf = (bf16x8){lo[0], lo[1], lo[2], lo[3], hh[0], hh[1], hh[2], hh[3]};
                        o[dh] = __builtin_amdgcn_mfma_f32_32x32x16_bf16(pa, vf, o[dh], 0, 0, 0); } } } }
        store_o(o, 1.0f / l, wsf, stg, T.O + (size_t)(row0 + 32 * qt) * 1024 + h * 64, 1024, lane);
    }
}

constexpr int B_KSZ = 12288, B_VSZ = 8192, B_K = 0, B_V = 4 * B_KSZ, B_WSF = B_V + 3 * B_VSZ, B_OST = B_WSF + 2048, B_GQ = B_OST + 8 * 4096, B_END = B_GQ + 512;
struct AttnB { const bf16_t *QR, *KF, *VF; bf16_t* O; const float* cst; const float* qg; const float* kg; };
__device__ __forceinline__ void attnB_prime(ALAS char* lds, const AttnB& T, int wv) {
    int tid = tid_of(wv);
    if (tid < 96) { const float kgv = T.kg[tid < 64 ? tid : 0]; ((ALAS float*)(lds + B_GQ))[tid] = T.qg[tid] * (tid < 64 ? kgv : 1.0f); }
    __syncthreads();
}
__device__ __forceinline__ void glds16(const void* gsrc, unsigned lds_dst) { unsigned keep;
    asm volatile("s_mov_b32 %0, m0\n\ts_mov_b32 m0, %2\n\ts_nop 0\n\tglobal_load_lds_dwordx4 %1, off\n\ts_mov_b32 m0, %0" : "=&s"(keep) : "v"(gsrc), "s"(lds_dst) : "memory"); }
__device__ __forceinline__ void kload2(bf16x8* kf, const ALAS char* kp, int j, int dst) { kf[2 * dst] = *(const ALAS bf16x8*)(kp + j * 2048); kf[2 * dst + 1] = *(const ALAS bf16x8*)(kp + j * 2048 + 512); }
__device__ __forceinline__ void bmask(f32x16& p0, f32x16& p1, int jb, int qrel, int hi) {
    const float NEG = -INFINITY; const int kb = 64 * jb + 4 * hi;
#pragma unroll
    for (int r = 0; r < 16; ++r) { const int kv = kb + (r & 3) + 8 * (r >> 2); if (kv > qrel) p0[r] = NEG; if (kv + 32 > qrel) p1[r] = NEG; }
}
#define B_SBAR() __builtin_amdgcn_sched_barrier(0)
#define PIN(x) asm volatile("" : "+v"(x))
#define B_MFMA(a, b, c) __builtin_amdgcn_mfma_f32_32x32x16_bf16(a, b, c, 0, 0, 0)
#define B_WAIT_BAR(N) asm volatile("s_waitcnt vmcnt(" #N ") lgkmcnt(0)\n\ts_barrier" ::: "memory")
__device__ __forceinline__ void attnB_qload(const AttnB& T, int b, int h, int qb, int wv, bf16x8 (&qraw)[6]) {
    int tid = tid_of(wv); const int lane = tid & 63, r32 = lane & 31, hi = lane >> 5; int w_ = wv; asm volatile("" : "+s"(w_));
#pragma unroll
    for (int d0 = 0; d0 < 6; ++d0) qraw[d0] = *(const bf16x8*)(T.QR + (size_t)(b * SEQ + qb * 256 + 32 * w_ + r32) * 1536 + h * 96 + d0 * 16 + hi * 8);
}
__device__ __forceinline__ void attnB_unit(ALAS char* lds, const AttnB& T, int b, int h, int qb, int wv, const bool pre, const bool nxt, const int nh, const int nqb, int& vs, bf16x8 (&qraw)[6]) {
    int tid = tid_of(wv); const int lane = tid & 63, r32 = lane & 31, hi = lane >> 5; int w_ = wv; asm volatile("" : "+s"(w_)); const int w = w_;
    const size_t rowb = (size_t)b * SEQ; const int q0 = qb * 256; const int NT = 4 * qb + 4;
    const unsigned lds0 = (unsigned)(uintptr_t)lds;
    const bf16_t* ksrc = T.KF + (rowb + lane) * 1536 + h * 96 + w * 8;
    const bf16_t* vsrc = T.VF + (rowb + 16 * (w & 3) + (lane >> 2)) * 1024 + h * 64 + (w >> 2) * 32 + (lane & 3) * 8;
    const unsigned kdst = lds0 + B_K + w * 1024, vdst = lds0 + B_V + w * 1024;
    const bool two = w < 4;
#define DMA_K(t, slot) do { glds16(ksrc + (size_t)(t) * 64 * 1536, (unsigned)__builtin_amdgcn_readfirstlane(kdst + (slot))); \
        if (two) glds16(ksrc + (size_t)(t) * 64 * 1536 + 64, (unsigned)__builtin_amdgcn_readfirstlane(kdst + (slot) + 8192)); } while (0)
#define DMA_V(t, slot) glds16(vsrc + (size_t)(t) * 64 * 1024, (unsigned)__builtin_amdgcn_readfirstlane(vdst + (slot)))
#define KSL(t) (((t) & 3) * B_KSZ)
    const ALAS char* kp0 = lds + B_K + hi * 1024 + r32 * 16;
    const ALAS char* vp0 = lds + B_V + ((lane >> 4) & 1) * 32 + (lane & 3) * 8 + (4 * hi + ((lane & 15) >> 2)) * 64;
    int sl_prev = vs * B_VSZ, sl_cur = sl_prev, sl_next = (vs == 2) ? 0 : sl_prev + B_VSZ;
    const int nvs = (vs + NT) % 3; vs = nvs;
    if (!pre) { asm volatile("s_waitcnt lgkmcnt(0)\n\ts_barrier" ::: "memory");
        DMA_K(0, 0); DMA_V(0, sl_cur); DMA_K(1, B_KSZ); DMA_K(2, 2 * B_KSZ); }
    bf16x8 qr[6];
    { const int qrow = (int)rowb + q0 + 32 * w + r32; float qv[6][8]; float ss = 0.f;
#pragma unroll
      for (int d0 = 0; d0 < 6; ++d0) { const bf16x8 raw = qraw[d0];
#pragma unroll
          for (int j = 0; j < 8; ++j) { const float f = __uint_as_float(((unsigned)(unsigned short)raw[j]) << 16); qv[d0][j] = f; ss += f * f; } }
      ss = xhalf_sum(ss); const float rq = rsqrtf(ss * (1.0f / 96.0f) + 1e-6f);
#pragma unroll
      for (int d0 = 0; d0 < 6; ++d0) { const f32x4 g0 = *(const ALAS f32x4*)(lds + B_GQ + (d0 * 16 + hi * 8) * 4), g1 = *(const ALAS f32x4*)(lds + B_GQ + (d0 * 16 + hi * 8 + 4) * 4);
#pragma unroll
          for (int j = 0; j < 4; ++j) { qv[d0][j] *= rq * g0[j]; qv[d0][j + 4] *= rq * g1[j]; } }
      { const f32x4 c0 = *(const f32x4*)(T.cst + (size_t)qrow * 32 + 8 * hi), c1 = *(const f32x4*)(T.cst + (size_t)qrow * 32 + 8 * hi + 4), s0 = *(const f32x4*)(T.cst + (size_t)qrow * 32 + 16 + 8 * hi), s1 = *(const f32x4*)(T.cst + (size_t)qrow * 32 + 16 + 8 * hi + 4);
#pragma unroll
        for (int j = 0; j < 8; ++j) { const float cs = j < 4 ? c0[j & 3] : c1[j & 3], sn = j < 4 ? s0[j & 3] : s1[j & 3]; const float t1 = qv[4][j], t2 = qv[5][j]; qv[4][j] = t1 * cs - t2 * sn; qv[5][j] = t2 * cs + t1 * sn; } }
      const float sc = 0.10206207261596575f * LOG2E;
#pragma unroll
      for (int d0 = 0; d0 < 6; ++d0) { u32x4 wq; wq.x = pkbf(qv[d0][0] * sc, qv[d0][1] * sc); wq.y = pkbf(qv[d0][2] * sc, qv[d0][3] * sc); wq.z = pkbf(qv[d0][4] * sc, qv[d0][5] * sc); wq.w = pkbf(qv[d0][6] * sc, qv[d0][7] * sc); qr[d0] = __builtin_bit_cast(bf16x8, wq); } }
    float mhat = 0.f, l_reg = 0.f; f32x16 o[2], negm; { float z_ = 0.f; asm volatile("" : "+v"(z_));
#pragma unroll
      for (int r = 0; r < 16; ++r) { o[0][r] = z_; o[1][r] = z_; negm[r] = z_; } }
    asm volatile("" : "+v"(negm));
    ALAS float* wsf = (ALAS float*)(lds + B_WSF) + w * 64; ALAS bf16_t* stg = (ALAS bf16_t*)(lds + B_OST + w * 4096);
    const int qrel = 32 * w + r32; bool resc = false;
    f32x16 pA0, pA1, pB0, pB1; bf16x8 kf[8]; s16x4 vlo[8], vhi[8]; u32x4 pw0, pw1, pw2, pw3;
#define ROT() do { sl_prev = sl_cur; sl_cur = sl_next; sl_next = (sl_next == 2 * B_VSZ) ? 0 : sl_next + B_VSZ; } while (0)
#define CMASK(P0, P1, t) do { const int jb_ = (t) - (NT - 4); if (jb_ >= 0) { asm volatile("s_nop 15\n\ts_nop 7" : "+v"(P0), "+v"(P1)); bmask(P0, P1, jb_, qrel, hi); } } while (0)
#define RESC() do { if (resc) { asm volatile("s_waitcnt lgkmcnt(0)" ::: "memory"); \
      _Pragma("unroll") for (int g_ = 0; g_ < 4; ++g_) { const f32x4 v_ = *(const ALAS f32x4*)(wsf + 8 * g_ + 4 * hi); \
          _Pragma("unroll") for (int e_ = 0; e_ < 4; ++e_) { o[0][4 * g_ + e_] *= v_[e_]; o[1][4 * g_ + e_] *= v_[e_]; } } } } while (0)
    B_WAIT_BAR(0);
    DMA_K(3, 3 * B_KSZ); DMA_V(1, sl_next);
    { const ALAS char* kb = kp0;
#pragma unroll
      for (int d0 = 0; d0 < 6; ++d0) { const bf16x8 k0 = *(const ALAS bf16x8*)(kb + d0 * 2048), k1 = *(const ALAS bf16x8*)(kb + d0 * 2048 + 512);
          if (d0 == 0) { pA0 = B_MFMA(k0, qr[0], negm); pA1 = B_MFMA(k1, qr[0], negm); } else { pA0 = B_MFMA(k0, qr[d0], pA0); pA1 = B_MFMA(k1, qr[d0], pA1); } } }
    asm volatile("s_nop 15\n\ts_nop 7" : "+v"(pA0), "+v"(pA1));
    if (NT == 4) bmask(pA0, pA1, 0, qrel, hi);
    { float rm = -INFINITY;
#pragma unroll
      for (int r = 0; r < 16; ++r) rm = fmaxf(rm, fmaxf(pA0[r], pA1[r]));
      rm = xhalf_max(rm); mhat = rm;
#pragma unroll
      for (int r = 0; r < 16; ++r) { pA0[r] = __builtin_amdgcn_exp2f(pA0[r] - rm); pA1[r] = __builtin_amdgcn_exp2f(pA1[r] - rm); }
#pragma unroll
      for (int r = 0; r < 16; ++r) negm[r] = -mhat;
      asm volatile("" : "+v"(negm)); }
    B_SBAR(); PIN(pA0); PIN(pA1);
    ROT();
    kload2(kf, kp0 + KSL(1), 0, 0); kload2(kf, kp0 + KSL(1), 1, 1);
    if (two) { B_WAIT_BAR(3); } else { B_WAIT_BAR(2); }
#define PKW(P, B) pkbf(P[B], P[(B) + 1])
#define PAF(k) __builtin_bit_cast(bf16x8, pw##k)
#define VFR(i) (bf16x8){vlo[i][0], vlo[i][1], vlo[i][2], vlo[i][3], vhi[i][0], vhi[i][1], vhi[i][2], vhi[i][3]}
#define MX3(a, b, c) __builtin_fmaxf(__builtin_fmaxf((a), (b)), (c))
#define GAPA(MF, A0, A1, A2, A3, W0, W1, PW) do { MF; sacc += A0; sacc += A1; sacc += A2; sacc += A3; PIN(sacc); W0; W1; PIN(PW); B_SBAR(); } while (0)
#define EX(v) __builtin_amdgcn_exp2f(v)
#define GAPB(MF, X, B) do { MF; X[B] = EX(X[B]); X[(B) + 1] = EX(X[(B) + 1]); X[(B) + 2] = EX(X[(B) + 2]); X[(B) + 3] = EX(X[(B) + 3]); PIN(X); B_SBAR(); } while (0)
#define VRD(i) do { vlo[i] = vtr(vp_ + (((i) >> 2) * 4096 + ((i) & 3) * 1024)); vhi[i] = vtr(vp_ + (((i) >> 2) * 4096 + ((i) & 3) * 1024 + 512)); } while (0)
#define KRD(G, j) do { if (G) { kload2(kf, kp0 + KSL((t_) + 1), j, j); B_SBAR(); } } while (0)
#define STEP(C0, C1, P0, P1, t, GK, GV, GL) do { B_SBAR(); const int t_ = (t); \
    asm volatile("" : "=v"(pw0), "=v"(pw1), "=v"(pw2), "=v"(pw3));        \
    const ALAS char* vp_ = vp0 + sl_prev; const ALAS char* kr_ = kp0 + KSL(t_); \
    float sacc = (P0[0] + P0[1]); \
    kload2(kf, kr_, 2, 2); B_SBAR(); GAPA(C0 = B_MFMA(kf[0], qr[0], negm), P0[2], P0[3], P0[4], P0[5],     pw0[0] = PKW(P0, 0),  pw0[1] = PKW(P0, 2),  pw0); \
    kload2(kf, kr_, 3, 3); B_SBAR(); GAPA(C1 = B_MFMA(kf[1], qr[0], negm), P0[6], P0[7], P0[8], P0[9],     pw0[2] = PKW(P0, 4),  pw0[3] = PKW(P0, 6),  pw0); \
    VRD(0); B_SBAR(); GAPA(C0 = B_MFMA(kf[2], qr[1], C0),   P0[10], P0[11], P0[12], P0[13], pw1[0] = PKW(P0, 8),  pw1[1] = PKW(P0, 10), pw1); \
    VRD(4); B_SBAR(); GAPA(C1 = B_MFMA(kf[3], qr[1], C1),   P0[14], P0[15], P1[0], P1[1],   pw1[2] = PKW(P0, 12), pw1[3] = PKW(P0, 14), pw1); \
    kload2(kf, kr_, 4, 0); VRD(1); B_SBAR(); GAPA(C0 = B_MFMA(kf[4], qr[2], C0),   P1[2], P1[3], P1[4], P1[5],     pw2[0] = PKW(P1, 0),  pw2[1] = PKW(P1, 2),  pw2); \
    kload2(kf, kr_, 5, 1); VRD(5); B_SBAR(); GAPA(C1 = B_MFMA(kf[5], qr[2], C1),   P1[6], P1[7], P1[8], P1[9],     pw2[2] = PKW(P1, 4),  pw2[3] = PKW(P1, 6),  pw2); \
    VRD(2); B_SBAR(); GAPA(C0 = B_MFMA(kf[6], qr[3], C0),   P1[10], P1[11], P1[12], P1[13], pw3[0] = PKW(P1, 8),  pw3[1] = PKW(P1, 10), pw3); \
    VRD(6); B_SBAR(); GAPA(C1 = B_MFMA(kf[7], qr[3], C1),   P1[14], P1[15], 0.f, 0.f,       pw3[2] = PKW(P1, 12), pw3[3] = PKW(P1, 14), pw3); \
    l_reg += sacc; \
    VRD(3); B_SBAR(); C0 = B_MFMA(kf[0], qr[4], C0); B_SBAR(); VRD(7); B_SBAR(); C1 = B_MFMA(kf[1], qr[4], C1); B_SBAR(); C0 = B_MFMA(kf[2], qr[5], C0); B_SBAR(); C1 = B_MFMA(kf[3], qr[5], C1); B_SBAR(); \
    if (GK) { DMA_K(t_ + 3, KSL(t_ + 3)); } if (GV) { DMA_V(t_ + 1, sl_next); } NXTH(); \
    CMASK(C0, C1, t_); \
    { float a = MX3(C0[0], C0[1], C1[0]), b_ = MX3(C0[2], C0[3], C1[1]); a = MX3(a, C1[2], C1[3]); \
      _Pragma("unroll") for (int r = 4; r < 16; r += 4) { a = MX3(a, C0[r], C0[r + 1]); b_ = MX3(b_, C0[r + 2], C0[r + 3]); a = MX3(a, C1[r], C1[r + 1]); b_ = MX3(b_, C1[r + 2], C1[r + 3]); } \
      float rm = xhalf_max(__builtin_fmaxf(a, b_)); \
      resc = false; \
      if (__builtin_expect(__any(rm > 8.0f), 0)) { const float dl = __builtin_fmaxf(rm, 0.f); mhat += dl; \
        _Pragma("unroll") for (int r = 0; r < 16; ++r) { C0[r] -= dl; C1[r] -= dl; } \
        _Pragma("unroll") for (int r = 0; r < 16; ++r) negm[r] = -mhat; asm volatile("" : "+v"(negm)); \
        const float f = __builtin_amdgcn_exp2f(-dl); l_reg *= f; if (hi == 0) wsf[r32] = f; resc = true; } } \
    B_SBAR(); \
    GAPB(o[0] = B_MFMA(PAF(0), VFR(0), o[0]), C0, 0); \
    GAPB(o[1] = B_MFMA(PAF(0), VFR(4), o[1]), C0, 4); \
    KRD(GL, 0); GAPB(o[0] = B_MFMA(PAF(1), VFR(1), o[0]), C0, 8); \
    KRD(GL, 1); GAPB(o[1] = B_MFMA(PAF(1), VFR(5), o[1]), C0, 12); \
    GAPB(o[0] = B_MFMA(PAF(2), VFR(2), o[0]), C1, 0); \
    GAPB(o[1] = B_MFMA(PAF(2), VFR(6), o[1]), C1, 4); \
    GAPB(o[0] = B_MFMA(PAF(3), VFR(3), o[0]), C1, 8); \
    GAPB(o[1] = B_MFMA(PAF(3), VFR(7), o[1]), C1, 12); \
    } while (0)
#define STEADYW() do { if (two) { B_WAIT_BAR(3); } else { B_WAIT_BAR(2); } } while (0)
#define ENDW(tt) do { if ((tt) + 3 < NT) { STEADYW(); } else if ((tt) + 2 < NT) { B_WAIT_BAR(1); } else { B_WAIT_BAR(0); } } while (0)
#define NXTH() do { } while (0)
    int t = 1;
    do {
        STEP(pB0, pB1, pA0, pA1, t, (t + 3 < NT), (t + 1 < NT), (t + 1 < NT));         ENDW(t);     RESC(); ROT();
        STEP(pA0, pA1, pB0, pB1, t + 1, (t + 4 < NT), (t + 2 < NT), (t + 2 < NT));     ENDW(t + 1); RESC(); ROT();
        t += 2;
    } while (t + 1 < NT);
#undef NXTH
#define NXTH() do { if (nxt) { const bf16_t* ksn_ = ksrc + (nh - h) * 96; const bf16_t* vsn_ = vsrc + (nh - h) * 64; \
        _Pragma("unroll") for (int i_ = 0; i_ < 3; ++i_) { glds16(ksn_ + (size_t)i_ * 64 * 1536, (unsigned)__builtin_amdgcn_readfirstlane(kdst + i_ * B_KSZ)); \
            if (two) glds16(ksn_ + (size_t)i_ * 64 * 1536 + 64, (unsigned)__builtin_amdgcn_readfirstlane(kdst + i_ * B_KSZ + 8192)); } \
        glds16(vsn_, (unsigned)__builtin_amdgcn_readfirstlane(vdst + nvs * B_VSZ)); } } while (0)
    STEP(pB0, pB1, pA0, pA1, NT - 1, false, false, false); RESC();
    { float sacc = pB0[0] + pB0[1];
#pragma unroll
      for (int r = 2; r < 16; ++r) sacc += pB0[r];
#pragma unroll
      for (int r = 0; r < 16; ++r) sacc += pB1[r];
      l_reg += sacc;
      pw0 = (u32x4){PKW(pB0, 0), PKW(pB0, 2), PKW(pB0, 4), PKW(pB0, 6)}; pw1 = (u32x4){PKW(pB0, 8), PKW(pB0, 10), PKW(pB0, 12), PKW(pB0, 14)};
      pw2 = (u32x4){PKW(pB1, 0), PKW(pB1, 2), PKW(pB1, 4), PKW(pB1, 6)}; pw3 = (u32x4){PKW(pB1, 8), PKW(pB1, 10), PKW(pB1, 12), PKW(pB1, 14)};
      const ALAS char* vp_ = vp0 + sl_cur;
#pragma unroll
      for (int i = 0; i < 8; ++i) VRD(i);
      o[0] = B_MFMA(PAF(0), VFR(0), o[0]); o[1] = B_MFMA(PAF(0), VFR(4), o[1]); o[0] = B_MFMA(PAF(1), VFR(1), o[0]); o[1] = B_MFMA(PAF(1), VFR(5), o[1]);
      o[0] = B_MFMA(PAF(2), VFR(2), o[0]); o[1] = B_MFMA(PAF(2), VFR(6), o[1]); o[0] = B_MFMA(PAF(3), VFR(3), o[0]); o[1] = B_MFMA(PAF(3), VFR(7), o[1]); }
    l_reg = xhalf_sum(l_reg);
    if (nxt) {
#pragma unroll
        for (int d0 = 0; d0 < 6; ++d0) qraw[d0] = *(const bf16x8*)(T.QR + (size_t)((int)rowb + nqb * 256 + 32 * w + r32) * 1536 + nh * 96 + d0 * 16 + hi * 8); }
    store_o(o, 1.0f / l_reg, wsf, stg, T.O + (rowb + q0 + 32 * w) * 1024 + h * 64, 1024, lane);
#undef PKW
#undef PAF
#undef VFR
#undef PIN
#undef MX3
#undef GAPA
#undef GAPB
#undef EX
#undef VRD
#undef KRD
#undef STEP
#undef STEADYW
#undef ENDW
#undef NXTH
#undef CMASK
#undef RESC
#undef ROT
#undef DMA_K
#undef DMA_V
#undef KSL
}
}
namespace mk {
#define LAS __attribute__((address_space(3)))
typedef unsigned short bf16;
typedef unsigned v4u __attribute__((ext_vector_type(4)));
typedef float f32x4 __attribute__((ext_vector_type(4)));
constexpr int M = 16384, D = 1024, FF = 2816, S = 2048, NB = 8, NWAVES = 8;
constexpr size_t MiB = 1u << 20, KiB = 1u << 10;
constexpr size_t WS_CTL = 0, CTL_BYTES = 1 * MiB;
constexpr size_t WS_SSP = 1 * MiB;
constexpr size_t WS_SSQ = 2 * MiB, WS_SSKV = 2 * MiB + 256 * KiB, WS_SSR = 2 * MiB + 512 * KiB, WS_KR = 3 * MiB, WS_CST = 5 * MiB;
constexpr size_t SZ_GU = (size_t)2 * FF * D * 2, SZ_DN = (size_t)D * FF * 2, SZ_AIN = (size_t)1280 * D * 2, SZ_SQ = (size_t)D * D * 2, SZ_BIN = (size_t)512 * D * 2, SZ_UQ = (size_t)1536 * 256 * 2, SZ_UKV = (size_t)2048 * 256 * 2;
constexpr size_t W_GU1_0 = 8 * MiB, W_D1_0 = W_GU1_0 + SZ_GU, W_AIN = W_D1_0 + SZ_DN, W_AOUT = W_AIN + SZ_AIN, W_GU2_0 = W_AOUT + SZ_SQ, W_D2_0 = W_GU2_0 + SZ_GU, W_GU1_1 = W_D2_0 + SZ_DN, W_D1_1 = W_GU1_1 + SZ_GU,
                 W_BIN = W_D1_1 + SZ_DN, W_UQ = W_BIN + SZ_BIN, W_UKV = W_UQ + SZ_UQ, W_BOUT = W_UKV + SZ_UKV, W_GU2_1 = W_BOUT + SZ_SQ, W_D2_1 = W_GU2_1 + SZ_GU, W_END = W_D2_1 + SZ_DN;
constexpr size_t WS_XB = 84 * MiB;
constexpr size_t WS_BIG = 116 * MiB;
constexpr size_t WS_H = WS_BIG;
constexpr size_t WS_QA = 204 * MiB, WS_OA = WS_QA, WS_KA = 236 * MiB, WS_VA = 240 * MiB;
constexpr size_t WS_QR = WS_BIG, WS_KF = WS_BIG + 48 * MiB, WS_VF = WS_BIG + 96 * MiB;
constexpr size_t WS_OB = 8 * MiB, WS_CQ = 40 * MiB, WS_CKV = 48 * MiB;
constexpr size_t WS_END = 256 * MiB;
static_assert(WS_CST + (size_t)M * 32 * 4 <= W_GU1_0 && W_END <= WS_XB && WS_XB + (size_t)M * D * 2 <= WS_BIG && WS_H + (size_t)M * FF * 2 <= WS_END && WS_VF + (size_t)M * 1024 * 2 <= WS_END && WS_CKV + (size_t)M * 256 * 2 <= W_BIN && WS_VA + (size_t)M * 128 * 2 <= WS_END && WS_H + (size_t)M * FF * 2 <= WS_QA, "d_ws map");
constexpr int LDS_BYTES = 147456;
static_assert(att::A_END <= 131072 && att::B_END <= 131072, "attention LDS");

#define XB_TMO      128
#define XB_XCNT(j)  (256  + 64 * (j))
#define XB_XSUB(j)  (1280 + 64 * (j))
#define XB_XGEN(j)  (2304 + 64 * (j))
#define XB_TOP      3328
#define XB_TOPGEN   3392
#define XCD_BAR_WORDS 3456
#define XB_SPIN_CAP (1u << 18)

__device__ __forceinline__ unsigned xb_ld(unsigned* p)              { return __hip_atomic_load(p, __ATOMIC_RELAXED, __HIP_MEMORY_SCOPE_AGENT); }
__device__ __forceinline__ unsigned xb_add(unsigned* p, unsigned v) { return __hip_atomic_fetch_add(p, v, __ATOMIC_RELAXED, __HIP_MEMORY_SCOPE_AGENT); }
__device__ __forceinline__ unsigned xb_xcc_id() { return (unsigned)__builtin_amdgcn_s_getreg((3 << 11) | 20) & 0xFu; }
#define XB_SPIN(cond, bar) do { unsigned _sp = 0; while (cond) { __builtin_amdgcn_s_sleep(1); \
    if ((++_sp & 255u) == 0u) { if (xb_ld(&(bar)[XB_TMO])) break; if (_sp > XB_SPIN_CAP) { atomicAdd(&(bar)[XB_TMO], 1u); break; } } } } while (0)

struct XcdBarrier {
    unsigned* bar; unsigned x;
    volatile LAS unsigned* st;
};

__device__ __forceinline__ XcdBarrier xcd_barrier_post(unsigned* bar, volatile LAS unsigned* st, const bool lead) {
    XcdBarrier b; b.bar = bar; b.x = xb_xcc_id(); b.st = st;
    if (lead) (void)xb_add(&bar[XB_XCNT(b.x)], 1u);
    return b;
}
__device__ __forceinline__ void xcd_barrier_complete(unsigned* bar, unsigned x, unsigned& nloc, unsigned& nx) {
    const unsigned G = gridDim.x * gridDim.y * gridDim.z;
    unsigned sum, cnt, mine, sp = 0u;
    for (;;) {
        sum = 0u; cnt = 0u; mine = 0u;
#pragma unroll
        for (unsigned j = 0; j < 16; ++j) { const unsigned c = xb_ld(&bar[XB_XCNT(j)]); sum += c; cnt += (c > 0u) ? 1u : 0u; mine = (j == x) ? c : mine; }
        if (sum == G) break;
        __builtin_amdgcn_s_sleep(1);
        if ((++sp & 255u) == 0u) { if (xb_ld(&bar[XB_TMO])) break; if (sp > XB_SPIN_CAP) { atomicAdd(&bar[XB_TMO], 1u); break; } }
    }
    nloc = mine > 0u ? mine : 1u; nx = cnt > 0u ? cnt : 1u;
}

__device__ __forceinline__ void xcd_barrier(const XcdBarrier& b, const bool lead) {
    asm volatile("s_waitcnt vmcnt(0)" ::: "memory");
    __syncthreads();
    if (lead) {
        unsigned* bar = b.bar;
        __builtin_amdgcn_s_waitcnt(0);
        unsigned nloc = b.st[0], nx = b.st[1];
        if (nloc == 0u) { xcd_barrier_complete(bar, b.x, nloc, nx); b.st[0] = nloc; b.st[1] = nx; }
        const unsigned old = xb_add(&bar[XB_XSUB(b.x)], 1u);
        const unsigned gen = old / nloc;
        if (old + 1u == (gen + 1u) * nloc) {
            __builtin_amdgcn_fence(__ATOMIC_RELEASE, "agent");
            asm volatile("s_waitcnt vmcnt(0)" ::: "memory");
            const unsigned og = xb_add(&bar[XB_TOP], 1u);
            const unsigned tg = og / nx;
            if (og + 1u == (tg + 1u) * nx) xb_add(&bar[XB_TOPGEN], 1u);
            else XB_SPIN(xb_ld(&bar[XB_TOPGEN]) == tg, bar);
            __builtin_amdgcn_fence(__ATOMIC_ACQUIRE, "agent");
            xb_add(&bar[XB_XGEN(b.x)], 1u);
            asm volatile("s_waitcnt vmcnt(0)" ::: "memory");
        } else {
            XB_SPIN(xb_ld(&bar[XB_XGEN(b.x)]) == gen, bar);
            __builtin_amdgcn_fence(__ATOMIC_ACQUIRE, "agent");
            asm volatile("s_waitcnt vmcnt(0)" ::: "memory");
        }
    }
    __syncthreads();
}

#define CW_GRP 8192
#define CW_XID 9216
#define CW_TEAM 10240
__device__ __forceinline__ void group_barrier(unsigned* bar, unsigned* cnt, unsigned nmem, volatile LAS unsigned* fastw, const bool lead) {
    asm volatile("s_waitcnt vmcnt(0)" ::: "memory");
    __syncthreads();
    if (lead) {
        if (fastw[0] == 0u) { __builtin_amdgcn_fence(__ATOMIC_RELEASE, "agent"); asm volatile("s_waitcnt vmcnt(0)" ::: "memory"); }
        const unsigned old = xb_add(cnt, 1u);
        const unsigned target = (old / nmem + 1u) * nmem;
        XB_SPIN(xb_ld(cnt) < target, bar);
        __builtin_amdgcn_fence(__ATOMIC_ACQUIRE, "agent");
        asm volatile("s_waitcnt vmcnt(0)" ::: "memory");
    }
    __syncthreads();
}

constexpr int CW_BAR = 4096;
constexpr int MISC_OFF = 131072 + 320;
constexpr int AUX_OFF = 131072 + 1024;
struct Args { const void* in[25]; float* out; unsigned char* ws; };
__device__ __forceinline__ int opq(int v) { asm volatile("" : "+s"(v)); return v; }
__device__ __forceinline__ unsigned char* opqp(unsigned char* p) { asm volatile("" : "+s"(p)); return p; }
static_assert((CW_BAR + XCD_BAR_WORDS) <= CW_GRP && (CW_XID + 1024) <= CW_TEAM && (CW_TEAM + 64 * 64) * 4 <= 64 * 1024, "barrier words inside the memset");


__device__ __forceinline__ float wave_sum(float v) {
#pragma unroll
    for (int o = 1; o < 64; o <<= 1) v += __shfl_xor(v, o);
    return v;
}
__device__ __forceinline__ unsigned f2bf(float f) { unsigned u = __builtin_bit_cast(unsigned, f); return (u + 0x7fffu + ((u >> 16) & 1u)) >> 16; }
__device__ __forceinline__ unsigned pk2(float lo, float hi) { return f2bf(lo) | (f2bf(hi) << 16); }

enum { K_NAT = 0, K_GU0 = 1, K_GU1 = 2, K_AIN = 3, K_BIN = 4, K_UKV = 5 };
struct Job { const float* w; const float* gain; bf16* dst; int kind, Kd, Ks, Ns; };
typedef unsigned u32x4 __attribute__((ext_vector_type(4)));
__device__ __forceinline__ void conv_item(const Job& J, int item, int lane) {
    const int nblk = (J.Ns + 63) >> 6, kb = item / nblk, nb = item - kb * nblk;
    const int g = lane >> 4, c = lane & 15, k0 = 64 * kb + 16 * g, col0 = 64 * nb + 4 * c;
    if (col0 >= J.Ns) return;
    const float* src = J.w + (size_t)k0 * J.Ns + col0;
    f32x4 v[16];
#pragma unroll
    for (int i = 0; i < 16; ++i) v[i] = __builtin_nontemporal_load((const f32x4*)(src + (size_t)i * J.Ns));
    if (J.gain) {
#pragma unroll
        for (int q = 0; q < 4; ++q) { const f32x4 gn = *(const f32x4*)(J.gain + k0 + 4 * q);
#pragma unroll
            for (int j = 0; j < 4; ++j) v[4 * q + j] = v[4 * q + j] * gn[j]; } }
    int r0 = col0;
    if (J.kind == K_GU0 || J.kind == K_GU1) r0 = 256 * (col0 >> 7) + (col0 & 127) + (J.kind == K_GU1 ? 128 : 0);
    else if (J.kind == K_AIN) { const int pn = col0 >> 8, wc = (col0 >> 6) & 3, bj = (col0 >> 5) & 1, i = col0 & 31; r0 = 256 * pn + 128 * bj + 32 * wc + i; }
    else if (J.kind == K_BIN) { if (col0 >= 384) { const int dd = col0 - 384; r0 = 384 + 8 * ((dd >> 2) & 3) + 4 * (dd >> 4) + (dd & 3); } }
    else if (J.kind == K_UKV) { const int head = col0 >> 7, t = col0 & 127, isv = t >> 6, tt = t & 63; r0 = 256 * ((head >> 2) + 4 * isv) + 128 * (tt >> 5) + 32 * (head & 3) + (tt & 31); }
#pragma unroll
    for (int e = 0; e < 4; ++e) { bf16* dp = J.dst + (size_t)(r0 + e) * J.Kd + k0;
        u32x4 w0, w1; w0.x = pk2(v[0][e], v[1][e]); w0.y = pk2(v[2][e], v[3][e]); w0.z = pk2(v[4][e], v[5][e]); w0.w = pk2(v[6][e], v[7][e]);
        w1.x = pk2(v[8][e], v[9][e]); w1.y = pk2(v[10][e], v[11][e]); w1.z = pk2(v[12][e], v[13][e]); w1.w = pk2(v[14][e], v[15][e]);
        *(u32x4*)dp = w0; *(u32x4*)(dp + 8) = w1; }
}
constexpr int NJOBS = 18;
__device__ __forceinline__ Job get_job(const Args& a, int j) {
    unsigned char* ws = a.ws; Job J;
    const float* ffn_norm1 = (const float*)a.in[3]; const float* ffn1_wg = (const float*)a.in[4]; const float* ffn1_wu = (const float*)a.in[5]; const float* ffn1_wd = (const float*)a.in[6];
    const float* mix_norm = (const float*)a.in[7]; const float* ffn_norm2 = (const float*)a.in[8]; const float* ffn2_wg = (const float*)a.in[9]; const float* ffn2_wu = (const float*)a.in[10]; const float* ffn2_wd = (const float*)a.in[11];
    const size_t GU = (size_t)D * FF;
    switch (j) {
        case 0:  J = Job{ffn1_wg, ffn_norm1, (bf16*)(ws + W_GU1_0), K_GU0, D, D, FF}; break;
        case 1:  J = Job{ffn1_wu, ffn_norm1, (bf16*)(ws + W_GU1_0), K_GU1, D, D, FF}; break;
        case 2:  J = Job{ffn1_wd, nullptr, (bf16*)(ws + W_D1_0), K_NAT, FF, FF, D}; break;
        case 3:  J = Job{(const float*)a.in[12], mix_norm, (bf16*)(ws + W_AIN), K_AIN, D, D, 1280}; break;
        case 4:  J = Job{(const float*)a.in[16], nullptr, (bf16*)(ws + W_AOUT), K_NAT, D, D, D}; break;
        case 5:  J = Job{ffn2_wg, ffn_norm2, (bf16*)(ws + W_GU2_0), K_GU0, D, D, FF}; break;
        case 6:  J = Job{ffn2_wu, ffn_norm2, (bf16*)(ws + W_GU2_0), K_GU1, D, D, FF}; break;
        case 7:  J = Job{ffn2_wd, nullptr, (bf16*)(ws + W_D2_0), K_NAT, FF, FF, D}; break;
        case 8:  J = Job{ffn1_wg + GU, ffn_norm1 + D, (bf16*)(ws + W_GU1_1), K_GU0, D, D, FF}; break;
        case 9:  J = Job{ffn1_wu + GU, ffn_norm1 + D, (bf16*)(ws + W_GU1_1), K_GU1, D, D, FF}; break;
        case 10: J = Job{ffn1_wd + GU, nullptr, (bf16*)(ws + W_D1_1), K_NAT, FF, FF, D}; break;
        case 11: J = Job{(const float*)a.in[17], mix_norm + D, (bf16*)(ws + W_BIN), K_BIN, D, D, 416}; break;
        case 12: J = Job{(const float*)a.in[20], (const float*)a.in[18], (bf16*)(ws + W_UQ), K_NAT, 256, 256, 1536}; break;
        case 13: J = Job{(const float*)a.in[21], (const float*)a.in[19], (bf16*)(ws + W_UKV), K_UKV, 128, 128, 2048}; break;
        case 14: J = Job{(const float*)a.in[24], nullptr, (bf16*)(ws + W_BOUT), K_NAT, D, D, D}; break;
        case 15: J = Job{ffn2_wg + GU, ffn_norm2 + D, (bf16*)(ws + W_GU2_1), K_GU0, D, D, FF}; break;
        case 16: J = Job{ffn2_wu + GU, ffn_norm2 + D, (bf16*)(ws + W_GU2_1), K_GU1, D, D, FF}; break;
        default: J = Job{ffn2_wd + GU, nullptr, (bf16*)(ws + W_D2_1), K_NAT, FF, FF, D}; break;
    }
    return J;
}
__device__ __forceinline__ void convert_jobs(const Args& a, int jlo, int jhi, int wk, int nwg, int wv, int) {
    int tid = tid_of(wv);
    const int lane = tid & 63, wave = wv;
    const int gw = wk * NWAVES + wave, NGW = nwg * NWAVES;
    int base = 0;
    for (int j = jlo; j < jhi; ++j) {
        const Job J = get_job(a, j); const int nitems = (J.Ks >> 6) * ((J.Ns + 63) >> 6);
        const int first = (gw - base % NGW + NGW) % NGW;
        for (int it = first; it < nitems; it += NGW) conv_item(J, it, lane);
        base += nitems;
    }
}
__device__ __forceinline__ void zero_pads(const Args& a, int wk, int nwg, int wv, int) {
    int tid = tid_of(wv);
    const int lane = tid & 63, wave = wv;
    const int gw = wk * NWAVES + wave, NGW = nwg * NWAVES;
    unsigned zz = 0u; asm volatile("" : "+v"(zz)); const u32x4 z = (u32x4){zz, zz, zz, zz}; u32x4* bin = (u32x4*)(a.ws + W_BIN + (size_t)416 * D * 2);
    for (int e = gw * 64 + lane; e < 96 * 128; e += NGW * 64) bin[e] = z;
}
__device__ __forceinline__ void prologue(const Args& a, int vcu, int G, int wave, int lane) {
    const int gw = vcu * NWAVES + wave, NGW = G * NWAVES;
    convert_jobs(a, 0, 4, vcu, G, wave, lane);
    const float* x = (const float*)a.in[0]; bf16* xb = (bf16*)(a.ws + WS_XB); float* ssp = (float*)(a.ws + WS_SSP);
    for (int m = gw; m < M; m += NGW) {
        const f32x4* xr = (const f32x4*)(x + (size_t)m * D) + lane; f32x4 v[4]; float s = 0.f;
#pragma unroll
        for (int j = 0; j < 4; ++j) { v[j] = xr[64 * j]; s += (v[j][0] * v[j][0] + v[j][1] * v[j][1]) + (v[j][2] * v[j][2] + v[j][3] * v[j][3]); }
        s = wave_sum(s);
        unsigned long long* o8 = (unsigned long long*)(xb + (size_t)m * D) + lane;
#pragma unroll
        for (int j = 0; j < 4; ++j) o8[64 * j] = (unsigned long long)pk2(v[j][0], v[j][1]) | ((unsigned long long)pk2(v[j][2], v[j][3]) << 32);
        if (lane < 16) ssp[(size_t)m * 16 + lane] = lane == 0 ? s : 0.f;
    }
    { const int* pos = (const int*)a.in[1]; float* cst = (float*)(a.ws + WS_CST);
      for (int e = gw * 64 + lane; e < M * 16; e += NGW * 64) { const int m = e >> 4, i = e & 15; float cs, sn; pg8::rope_cs((float)pos[m], i, cs, sn); cst[(size_t)m * 32 + i] = cs; cst[(size_t)m * 32 + 16 + i] = sn; } }
}
#ifndef PROBE
#define PROBE 0
#endif
__global__ void __launch_bounds__(NWAVES * 64, 2) mega(Args a) {
    extern __shared__ __attribute__((aligned(16))) unsigned char lds_raw[];
    LAS unsigned char* lds = (LAS unsigned char*)lds_raw;
    const int wave = __builtin_amdgcn_readfirstlane((int)threadIdx.x >> 6);
#define tid tid_of(wave)
#define lane (tid_of(wave) & 63)
    const int G = gridDim.x, bx = blockIdx.x; const int vcu = (G % 8 == 0) ? (bx % 8) * (G / 8) + bx / 8 : bx;
    unsigned char* ws = a.ws;
    float* X = a.out; bf16* XB = (bf16*)(ws + WS_XB); float* SSP = (float*)(ws + WS_SSP);
    volatile LAS unsigned* MISC = (volatile LAS unsigned*)(lds + MISC_OFF);
    if (tid < 32) MISC[tid] = 0u;
    __syncthreads();
    const XcdBarrier bar = xcd_barrier_post((unsigned*)(ws + WS_CTL) + CW_BAR, MISC + 8, tid == 0);
    const bool use_grp = (G % 8 == 0) && G <= 1024;
    if (tid == 0) __hip_atomic_store((unsigned*)(ws + WS_CTL) + CW_XID + bx, 1u + xb_xcc_id(), __ATOMIC_RELAXED, __HIP_MEMORY_SCOPE_AGENT);
#define GRID_SYNC() do { XcdBarrier b_ = bar; asm volatile("" : "+s"(b_.bar), "+s"(b_.x)); xcd_barrier(b_, tid == 0); } while (0)
#define XBp() ((bf16*)(opqp(a.ws) + WS_XB))
#define SSPp() ((float*)(opqp(a.ws) + WS_SSP))
#define Xp() ((float*)opqp((unsigned char*)a.out))
    for (int rep = 0; rep < (PROBE == 1 ? 2 : 1); ++rep) prologue(a, vcu, G, wave, lane);
    GRID_SYNC();
    if (PROBE == 2) for (int rep = 0; rep < 10; ++rep) GRID_SYNC();
    if (tid == 0) {
        unsigned same = use_grp ? 1u : 0u; const unsigned mine = 1u + xb_xcc_id();
        for (int j = bx & 7; j < G && use_grp; j += 8) same &= (__hip_atomic_load((unsigned*)(ws + WS_CTL) + CW_XID + j, __ATOMIC_RELAXED, __HIP_MEMORY_SCOPE_AGENT) == mine) ? 1u : 0u;
        MISC[10] = same; }
    __syncthreads();
#define GROUP_SYNC() do { if (use_grp) { unsigned* cw_ = (unsigned*)(ws + WS_CTL); asm volatile("" : "+s"(cw_)); group_barrier(cw_ + CW_BAR, cw_ + CW_GRP + 64 * (bx & 7), (unsigned)opq(G >> 3), MISC + 10, tid == 0); } else GRID_SYNC(); } while (0)
    const bool use_team = use_grp && (G % 64 == 0);
#define TEAM_SYNC() do { if (use_team) { unsigned* cw_ = (unsigned*)(ws + WS_CTL); asm volatile("" : "+s"(cw_)); group_barrier(cw_ + CW_BAR, cw_ + CW_TEAM + 64 * opq(((bx & 7) << 3) | ((bx >> 3) & 7)), (unsigned)opq(G >> 6), MISC + 10, tid == 0); } else GROUP_SYNC(); } while (0)
    for (int L = 0; L < 2; ++L) {
        for (int half = 0; half < 2; ++half) {
            { const size_t woff = (L == 0) ? (half == 0 ? W_GU1_0 : W_GU2_0) : (half == 0 ? W_GU1_1 : W_GU2_1);
              const bool tailconv = (L == 1 && half == 0);
              pg8::Gemm g{XBp(), (const bf16*)(opqp(a.ws) + woff), M, 2 * FF, D}; pg8::HalfTailOrder So; So.init(M, 2 * FF, opq(G), opq(bx)); So.use_half = false;
              LAS float* rsl = (LAS float*)(lds + AUX_OFF);
              pg8::EpiSwiGLU E{(bf16*)(opqp(a.ws) + WS_H), FF, rsl, SSPp()};
              for (int rep = 0; rep < (PROBE == 5 ? 2 : 1); ++rep) pg8::gemm_phase<pg8::EpiSwiGLU, pg8::HalfTailOrder, true, true>(lds, g, So, E, wave);
              if (tailconv) { const int nidle = G - (64 * 22) % G;
                  if (nidle > 0 && nidle < G) { if (bx >= G - nidle) { convert_jobs(a, 11, 18, bx - (G - nidle), nidle, wave, lane); zero_pads(a, bx - (G - nidle), nidle, wave, lane); } }
                  else { convert_jobs(a, 11, 18, bx, G, wave, lane); zero_pads(a, bx, G, wave, lane); } } }
            TEAM_SYNC();
            { const size_t woff = (L == 0) ? (half == 0 ? W_D1_0 : W_D2_0) : (half == 0 ? W_D1_1 : W_D2_1);
              pg8::Gemm g{(const bf16*)(opqp(a.ws) + WS_H), (const bf16*)(opqp(a.ws) + woff), M, D, FF}; pg8::StaticOrder So; So.init(M, D, opq(G), opq(bx));
              pg8::EpiResid E{(const float*)Xp(), Xp(), XBp(), SSPp(), 0.5f, L == 1 && half == 1};
              for (int rep = 0; rep < (PROBE == 6 ? 2 : 1); ++rep) { pg8::gemm_phase<pg8::EpiResid, pg8::StaticOrder, true, true>(lds, g, So, E, wave); E.R = Xp(); E.alpha = 0.f; } }
            if (L == 1 && half == 1) break;
            if (L == 1 && half == 0) GRID_SYNC(); else TEAM_SYNC();
            if (half == 1) continue;
            const bf16* Oat; const bf16* Wout;
            if (L == 0) {
                { pg8::Gemm g{XBp(), (const bf16*)(opqp(a.ws) + W_AIN), M, 1280, D}; pg8::StaticOrder So; So.init(M, 1280, opq(G), opq(bx));
                  pg8::EpiQKV E{(bf16*)(opqp(a.ws) + WS_QA), (bf16*)(opqp(a.ws) + WS_KA), (bf16*)(opqp(a.ws) + WS_VA), SSPp(), (const float*)a.in[13], (const float*)a.in[14], 0.125f * 1.4426950408889634f, (LAS float*)(lds + AUX_OFF)};
                  for (int rep = 0; rep < (PROBE == 8 ? 2 : 1); ++rep) pg8::gemm_phase<pg8::EpiQKV, pg8::StaticOrder, true, true>(lds, g, So, E, wave);
                  const int nidle = G - (64 * 5) % G;
                  if (nidle > 0 && nidle < G) { if (bx >= G - nidle) convert_jobs(a, 4, 11, bx - (G - nidle), nidle, wave, lane); }
                  else convert_jobs(a, 4, 11, bx, G, wave, lane); }
                GROUP_SYNC();
                { att::AttnA T{(const bf16*)(opqp(a.ws) + WS_QA), (const bf16*)(opqp(a.ws) + WS_KA), (const bf16*)(opqp(a.ws) + WS_VA), (bf16*)(opqp(a.ws) + WS_OA), (const int*)a.in[1], (const float*)a.in[2], (const float*)a.in[15]};
                  for (int rep = 0; rep < (PROBE == 3 ? 2 : 1); ++rep) if (use_grp) { for (int j = bx >> 3; j < 32; j += G >> 3) att::attnA_unit((LAS char*)lds, T, bx & 7, j >> 1, j & 1, wave); }
                  else for (int u = bx; u < NB * 16 * 2; u += G) att::attnA_unit((LAS char*)lds, T, u >> 5, (u >> 1) & 15, u & 1, wave);
                  __syncthreads(); }
                Oat = (const bf16*)(opqp(a.ws) + WS_OA); Wout = (const bf16*)(opqp(a.ws) + W_AOUT);
            } else {
                { pg8::Gemm g{XBp(), (const bf16*)(opqp(a.ws) + W_BIN), M, 512, D}; pg8::HalfTailOrder So; So.init(M, 512, opq(G), opq(bx)); So.use_half = true;
                  pg8::EpiBIn E{(bf16*)(opqp(a.ws) + WS_CQ), (bf16*)(opqp(a.ws) + WS_CKV), (float*)(opqp(a.ws) + WS_SSQ), (float*)(opqp(a.ws) + WS_SSKV), (float*)(opqp(a.ws) + WS_SSR), (float*)(opqp(a.ws) + WS_KR), SSPp(), (const float*)(opqp(a.ws) + WS_CST), (const float*)a.in[23], (LAS float*)(lds + AUX_OFF)};
                  for (int rep = 0; rep < (PROBE == 9 ? 2 : 1); ++rep) pg8::gemm_phase<pg8::EpiBIn, pg8::HalfTailOrder, true, true, true>(lds, g, So, E, wave); }
                GROUP_SYNC();
                { pg8::Gemm g{(const bf16*)(opqp(a.ws) + WS_CQ), (const bf16*)(opqp(a.ws) + W_UQ), M, 1536, 256}; pg8::HalfTailOrder So; So.init(M, 1536, opq(G), opq(bx)); So.use_half = true;
                  pg8::EpiUQ E{(bf16*)(opqp(a.ws) + WS_QR), (const float*)(opqp(a.ws) + WS_SSQ), (LAS float*)(lds + AUX_OFF)};
                  for (int rep = 0; rep < (PROBE == 9 ? 2 : 1); ++rep) pg8::gemm_phase<pg8::EpiUQ, pg8::HalfTailOrder, true, true, true>(lds, g, So, E, wave); }
                { pg8::Gemm g{(const bf16*)(opqp(a.ws) + WS_CKV), (const bf16*)(opqp(a.ws) + W_UKV), M, 2048, 128}; pg8::StaticOrder So; So.init(M, 2048, opq(G), opq(bx));
                  pg8::EpiUKV E{(bf16*)(opqp(a.ws) + WS_KF), (bf16*)(opqp(a.ws) + WS_VF), (const float*)(opqp(a.ws) + WS_SSKV), (const float*)(opqp(a.ws) + WS_SSR), (const float*)(opqp(a.ws) + WS_KR), (LAS float*)(lds + AUX_OFF)};
                  for (int rep = 0; rep < (PROBE == 9 ? 2 : 1); ++rep) pg8::gemm_phase<pg8::EpiUKV, pg8::StaticOrder, true, true>(lds, g, So, E, wave); }
                GROUP_SYNC();
                { att::AttnB T{(const bf16*)(opqp(a.ws) + WS_QR), (const bf16*)(opqp(a.ws) + WS_KF), (const bf16*)(opqp(a.ws) + WS_VF), (bf16*)(opqp(a.ws) + WS_OB), (const float*)(opqp(a.ws) + WS_CST), (const float*)a.in[22], (const float*)a.in[23]};
                  att::attnB_prime((LAS char*)lds, T, wave);
                  for (int rep = 0; rep < (PROBE == 4 ? 2 : 1); ++rep) { int vs = 0; att::bf16x8 qraw[6]; bool pre = false;
                      if (use_grp) { const int jst = G >> 3; { const int bo = opq(bx); const int jc = (bo >> 3) < 64 ? (bo >> 3) : 63; att::attnB_qload(T, bo & 7, jc >> 2, jc & 3, wave, qraw); }
                          for (int j = bx >> 3; j < 64; j += jst) { const int hh = j >> 2, s = j & 3; const bool more = j + jst < 64;
                          att::attnB_unit((LAS char*)lds, T, bx & 7, hh, s, wave, pre, true, hh, 7 - s, vs, qraw);
                          att::attnB_unit((LAS char*)lds, T, bx & 7, hh, 7 - s, wave, true, more, (j + jst) >> 2, (j + jst) & 3, vs, qraw); pre = true; } }
                      else for (int p = bx; p < NB * 16 * 4; p += G) { const int bh = p >> 2, s = p & 3; att::attnB_qload(T, bh >> 4, bh & 15, s, wave, qraw);
                          att::attnB_unit((LAS char*)lds, T, bh >> 4, bh & 15, s, wave, false, true, bh & 15, 7 - s, vs, qraw); att::attnB_unit((LAS char*)lds, T, bh >> 4, bh & 15, 7 - s, wave, true, false, 0, 0, vs, qraw); } }
                  asm volatile("s_waitcnt vmcnt(0) lgkmcnt(0)" ::: "memory"); __syncthreads(); }
                Oat = (const bf16*)(opqp(a.ws) + WS_OB); Wout = (const bf16*)(opqp(a.ws) + W_BOUT);
            }
            if (L == 0) GRID_SYNC(); else GROUP_SYNC();
            { pg8::Gemm g{Oat, Wout, M, D, D}; pg8::StaticOrder So; So.init(M, D, opq(G), opq(bx));
              pg8::EpiResid E{(const float*)Xp(), Xp(), XBp(), SSPp(), 1.0f, false};
              for (int rep = 0; rep < (PROBE == 7 ? 2 : 1); ++rep) { pg8::gemm_phase<pg8::EpiResid, pg8::StaticOrder, true, true>(lds, g, So, E, wave); E.alpha = 0.f; } }
            if (L == 1) GRID_SYNC(); else TEAM_SYNC();
        }
    }
}
#undef tid
#undef lane
}

extern "C" void kernel_launch(void* const* d_in, const int* in_sizes, int n_in, void* d_out, int out_size, void* d_ws, size_t ws_size, hipStream_t stream) {
    using namespace mk;
    static int grid = 0;
    if (grid == 0) {
        if (n_in != 25 || out_size != M * D || ws_size < WS_END) { fprintf(stderr, "kernel_launch: unexpected shapes (n_in %d out %d ws %zu)\n", n_in, out_size, ws_size); grid = -1; return; }
        int dev = 0, cus = 0, per_cu = 0;
        hipGetDevice(&dev); hipDeviceGetAttribute(&cus, hipDeviceAttributeMultiprocessorCount, dev);
        hipFuncSetAttribute((const void*)mega, hipFuncAttributeMaxDynamicSharedMemorySize, LDS_BYTES);
        hipOccupancyMaxActiveBlocksPerMultiprocessor(&per_cu, (const void*)mega, NWAVES * 64, LDS_BYTES);
        if (per_cu < 1) { fprintf(stderr, "kernel_launch: occupancy query says %d blocks per CU\n", per_cu); per_cu = 1; }
        (void)hipGetLastError();
        grid = cus;
    }
    if (grid < 0) return;
    Args a{};
    for (int i = 0; i < 25; ++i) a.in[i] = d_in[i];
    a.out = (float*)d_out; a.ws = (unsigned char*)d_ws;
    if (hipMemsetAsync((char*)d_ws + WS_CTL, 0, 64 * 1024, stream) != hipSuccess) { fprintf(stderr, "kernel_launch: memset failed\n"); return; }
    hipLaunchKernelGGL(mega, dim3(grid), dim3(NWAVES * 64), LDS_BYTES, stream, a);
    const hipError_t e = hipPeekAtLastError();
    if (e != hipSuccess) fprintf(stderr, "launch failed: %s (grid %d)\n", hipGetErrorName(e), grid);
}
```
